# Optimizing an MI355X kernel written in HIP

```python
import jax
import jax.numpy as jnp
from jax import lax
import numpy as np

D_MODEL = 4096
BATCH = 32
SEQ = 256
DEPTH = 1
DEC_BATCH = 4
DEC_SEQ = 2048
PAST_LEN = 256

GRID_W = 64
D_ATT = D_MODEL // 2
D_FOURIER = D_MODEL - D_ATT
D_MIX = D_ATT + D_FOURIER
HEAD_DIM = 128
N_HEADS = D_ATT // HEAD_DIM
N_FGROUPS = 4
FGROUP_DIM = D_FOURIER // N_FGROUPS
WIN_H = 8
WIN_W = 16
D_FF = ((8 * D_MODEL + 3 * 256 - 1) // (3 * 256)) * 256
Q_BLOCK = 128
EPS = 1e-6
NEG_INF = -1e30

kernel_name = "hybrid_natten_fnet_dit_step"


def rmsnorm(x, g):
    xf = x.astype(jnp.float32)
    y = xf * lax.rsqrt(jnp.mean(xf * xf, axis=-1, keepdims=True) + EPS)
    return (y * g.astype(jnp.float32)).astype(x.dtype)


def ada_mod(cvec, w_ada, b_ada):
    m = jax.nn.silu(cvec) @ w_ada + b_ada
    return jnp.split(m[:, None, :], 6, axis=-1)


def modulate(h, shift, scale):
    return h * (1 + scale) + shift


def swiglu(h, w_gate, w_up, w_down):
    return (jax.nn.silu(h @ w_gate) * (h @ w_up)) @ w_down


def mixer_split(h, w_in):
    b, t, _ = h.shape
    proj = h @ w_in
    q, k, v, u = jnp.split(proj, [D_ATT, 2 * D_ATT, 3 * D_ATT], axis=-1)
    return (q.reshape(b, t, N_HEADS, HEAD_DIM), k.reshape(b, t, N_HEADS, HEAD_DIM),
            v.reshape(b, t, N_HEADS, HEAD_DIM), u)


def fourier_mix(u):
    b, t, _ = u.shape
    ug = u.reshape(b, t, N_FGROUPS, FGROUP_DIM).astype(jnp.float32)
    f = jnp.fft.fft2(ug, axes=(1, 3), norm="ortho").real
    return f.reshape(b, t, D_FOURIER).astype(u.dtype)


def _dense_attend(q, k, v):
    s = jnp.einsum("bqhd,bkhd->bhqk", q, k).astype(jnp.float32) * (HEAD_DIM ** -0.5)
    p = jax.nn.softmax(s, axis=-1).astype(v.dtype)
    return jnp.einsum("bhqk,bkhd->bqhd", p, v)


def context_attention(q, k, v):
    b, s, h, d = q.shape
    qb = q.reshape(b, s // Q_BLOCK, Q_BLOCK, h, d).transpose(1, 0, 2, 3, 4)
    o = lax.map(lambda qi: _dense_attend(qi, k, v), qb)
    return o.transpose(1, 0, 2, 3, 4).reshape(b, s, h * d)


def neighbourhood_attention(q, k, v, k_ctx, v_ctx, rpb):
    b, t, h, d = q.shape
    rows = t // GRID_W
    win_h = min(WIN_H, rows)
    n_loc = win_h * GRID_W
    col = np.arange(GRID_W)
    cstart = np.clip(col - WIN_W // 2, 0, GRID_W - WIN_W)
    col_mask = (col[None, :] >= cstart[:, None]) & (col[None, :] < cstart[:, None] + WIN_W)
    dc_idx = jnp.asarray(np.clip(col[None, :] - col[:, None] + WIN_W - 1, 0, 2 * WIN_W - 2))
    mask = jnp.asarray(np.tile(col_mask, (1, win_h)))
    r = np.arange(rows)
    rstart = np.clip(r - WIN_H // 2, 0, rows - win_h)
    key_rows = rstart[:, None] + np.arange(win_h)[None, :]
    dr_idx = key_rows - r[:, None] + WIN_H - 1
    qg = q.reshape(b, rows, GRID_W, h, d).transpose(1, 0, 2, 3, 4)
    kg = k.reshape(b, rows, GRID_W, h, d)
    vg = v.reshape(b, rows, GRID_W, h, d)
    scale = d ** -0.5

    def row_block(args):
        q_r, rows_r, dr_r = args
        k_win = jnp.take(kg, rows_r, axis=1).reshape(b, n_loc, h, d)
        v_win = jnp.take(vg, rows_r, axis=1).reshape(b, n_loc, h, d)
        bias = rpb[:, dr_r[:, None, None], dc_idx[None, :, :]]
        bias = bias.transpose(0, 2, 1, 3).reshape(h, GRID_W, n_loc).astype(jnp.float32)
        s_loc = jnp.einsum("bqhd,bkhd->bhqk", q_r, k_win).astype(jnp.float32) * scale + bias
        s_loc = jnp.where(mask, s_loc, NEG_INF)
        s_ctx = jnp.einsum("bqhd,bkhd->bhqk", q_r, k_ctx).astype(jnp.float32) * scale
        p = jax.nn.softmax(jnp.concatenate([s_loc, s_ctx], axis=-1), axis=-1).astype(v.dtype)
        return (jnp.einsum("bhqk,bkhd->bqhd", p[..., :n_loc], v_win)
                + jnp.einsum("bhqk,bkhd->bqhd", p[..., n_loc:], v_ctx))

    o = lax.map(row_block, (qg, jnp.asarray(key_rows), jnp.asarray(dr_idx)))
    return o.transpose(1, 0, 2, 3, 4).reshape(b, t, h * d)


def setup_inputs(seed: int = 0) -> dict:
    key = jax.random.key(seed)
    ks = jax.random.split(key, 17)
    f32 = jnp.float32

    def nrm(k, shape, s=1.0):
        return jax.random.normal(k, shape, f32) * s

    return {
        "x_prompt": nrm(ks[0], (BATCH, SEQ, D_MODEL)),
        "x_sample": nrm(ks[1], (DEC_BATCH, DEC_SEQ, D_MODEL)),
        "cache_k": nrm(ks[2], (DEC_BATCH, DEPTH, PAST_LEN, N_HEADS, HEAD_DIM)),
        "cache_v": nrm(ks[3], (DEC_BATCH, DEPTH, PAST_LEN, N_HEADS, HEAD_DIM)),
        "c": nrm(ks[4], (DEC_BATCH, D_MODEL)),
        "c_ctx": nrm(ks[5], (D_MODEL,)),
        "w_ada": nrm(ks[6], (DEPTH, D_MODEL, 6 * D_MODEL), 0.5 * D_MODEL ** -0.5),
        "b_ada": nrm(ks[7], (DEPTH, 6 * D_MODEL), 0.01),
        "norm1_g": 1.0 + nrm(ks[8], (DEPTH, D_MODEL), 0.02),
        "w_in": nrm(ks[9], (DEPTH, D_MODEL, 3 * D_ATT + D_FOURIER), D_MODEL ** -0.5),
        "rpb": nrm(ks[10], (DEPTH, N_HEADS, 2 * WIN_H - 1, 2 * WIN_W - 1), 0.1),
        "w_out": nrm(ks[11], (DEPTH, D_MIX, D_MODEL), D_MIX ** -0.5),
        "norm2_g": 1.0 + nrm(ks[12], (DEPTH, D_MODEL), 0.02),
        "w_gate": nrm(ks[13], (DEPTH, D_MODEL, D_FF), D_MODEL ** -0.5),
        "w_up": nrm(ks[14], (DEPTH, D_MODEL, D_FF), D_MODEL ** -0.5),
        "w_down": nrm(ks[15], (DEPTH, D_FF, D_MODEL), D_FF ** -0.5),
        "final_g": 1.0 + nrm(ks[16], (D_MODEL,), 0.02),
    }


def reference(x_prompt, x_sample, cache_k, cache_v, c, c_ctx, w_ada, b_ada, norm1_g, w_in,
              rpb, w_out, norm2_g, w_gate, w_up, w_down, final_g):
    xp = x_prompt
    xs = x_sample
    new_k = []
    new_v = []
    for l in range(DEPTH):
        sh1, sc1, g1, sh2, sc2, g2 = ada_mod(c_ctx[None, :], w_ada[l], b_ada[l])
        h = modulate(rmsnorm(xp, norm1_g[l]), sh1, sc1)
        q, k, v, u = mixer_split(h, w_in[l])
        mix = jnp.concatenate([context_attention(q, k, v), fourier_mix(u)], axis=-1)
        xp = xp + g1 * (mix @ w_out[l])
        h = modulate(rmsnorm(xp, norm2_g[l]), sh2, sc2)
        xp = xp + g2 * swiglu(h, w_gate[l], w_up[l], w_down[l])
        new_k.append(k)
        new_v.append(v)
        sh1, sc1, g1, sh2, sc2, g2 = ada_mod(c, w_ada[l], b_ada[l])
        h = modulate(rmsnorm(xs, norm1_g[l]), sh1, sc1)
        q, k, v, u = mixer_split(h, w_in[l])
        att = neighbourhood_attention(q, k, v, cache_k[:, l], cache_v[:, l], rpb[l])
        mix = jnp.concatenate([att, fourier_mix(u)], axis=-1)
        xs = xs + g1 * (mix @ w_out[l])
        h = modulate(rmsnorm(xs, norm2_g[l]), sh2, sc2)
        xs = xs + g2 * swiglu(h, w_gate[l], w_up[l], w_down[l])
    y_prompt = rmsnorm(xp, final_g)
    y_sample = rmsnorm(xs, final_g)
    new_cache_k = jnp.stack(new_k, axis=1)
    new_cache_v = jnp.stack(new_v, axis=1)
    return (y_prompt, y_sample, new_cache_k, new_cache_v)
```

```cpp
#include <hip/hip_runtime.h>
#include <hip/hip_bf16.h>
#include <cstdio>
#include <cstdint>

#ifndef MK_N_LAUNCHES
#define MK_N_LAUNCHES 1
#endif

constexpr int DM = 4096, NTOK = 16384, NPROMPT = 8192, DATT = 2048, DFF = 11008, NH = 16, HD = 128;
constexpr int NMODV = 5, MODW = 6 * DM;
constexpr int KSPLIT = 16, KSPLIT2 = 32, MODC1 = 8192;
constexpr float EPS = 1e-6f;

constexpr size_t MiB = 1u << 20;
constexpr size_t WS_CTL = 0, CTL_ZERO_BYTES = 1 * MiB;
constexpr size_t WS_MODP = 1 * MiB;
constexpr size_t WS_MOD = 9 * MiB;
constexpr size_t WS_WIN = 10 * MiB;
constexpr size_t WS_WOUT = WS_WIN + 64 * MiB;
constexpr size_t WS_WGU = WS_WOUT + 32 * MiB;
constexpr size_t WS_WD = WS_WGU + 172 * MiB;
constexpr size_t WS_CK = WS_WD + 86 * MiB;
constexpr size_t WS_CV = WS_CK + 4 * MiB;
constexpr size_t WS_DT256 = WS_CV + 4 * MiB;
constexpr size_t WS_D2 = WS_DT256 + 1 * MiB;
constexpr size_t WS_DT2048 = WS_D2 + 2 * MiB;
constexpr size_t WS_H = WS_DT2048 + 16 * MiB;
constexpr size_t WS_MIX = WS_H + 128 * MiB;
constexpr size_t WS_QKV = WS_MIX + 128 * MiB;
constexpr size_t WS_UT = WS_QKV + 192 * MiB;
constexpr size_t WS_Y = WS_UT + 64 * MiB;
constexpr size_t WS_ACT = WS_QKV;
constexpr size_t WS_DL1 = WS_Y + 128 * MiB;
constexpr size_t WS_DL2 = WS_H;
constexpr size_t WS_MODP2 = WS_DL1 + 128 * MiB;
constexpr size_t WS_AMAXP = WS_MODP2 + 11 * MiB;
constexpr size_t WS_SW = WS_AMAXP + 2 * MiB;
constexpr size_t WS_SA = WS_SW + 1 * MiB;
constexpr size_t WS_AMAXD = WS_SA + 1 * MiB;
constexpr size_t WS_END = WS_AMAXD + 1 * MiB;
static_assert(WS_ACT + (size_t)NTOK * DFF * 2 <= WS_END, "ACT overlay");

constexpr int CW_BAR = 4096;

constexpr int RING_BYTES = 131072;
constexpr int LDSCTL_OFF = 146944, MISC_OFF = LDSCTL_OFF + 320;
constexpr int LDS_BYTES = 147456;

#define GAS __attribute__((address_space(1)))
#define LAS __attribute__((address_space(3)))
typedef unsigned short bf16;
typedef unsigned v4u __attribute__((ext_vector_type(4)));
typedef unsigned v2u __attribute__((ext_vector_type(2)));
typedef GAS unsigned gu32;
#define RLX_AGENT __ATOMIC_RELAXED, __HIP_MEMORY_SCOPE_AGENT
#define LDS_WAIT() asm volatile("s_waitcnt lgkmcnt(0)" ::: "memory")
#define VM_WAIT() asm volatile("s_waitcnt vmcnt(0)" ::: "memory")

namespace pg8 {
#define PG8_LAS __attribute__((address_space(3)))
typedef unsigned short bf16_t;
typedef short bf16x8 __attribute__((ext_vector_type(8)));
typedef float f32x4 __attribute__((ext_vector_type(4)));
typedef float f32x2 __attribute__((ext_vector_type(2)));
typedef unsigned u32x4 __attribute__((ext_vector_type(4)));
constexpr int BM = 256, BK = 64, HALF = 128, HTB = HALF * BK * 2, STAGE_BYTES = 8 * HTB, NXCD = 8, WGM = 8;

__host__ __device__ __forceinline__ int lds_byte(int r, int c) { const int st = (r >> 4) * 2 + (c >> 5), rr = r & 15, cc = c & 31, ob = rr * 64 + cc * 2; return st * 1024 + (ob ^ (((ob >> 9) & 1) << 5)); }
__host__ __device__ __forceinline__ void stage_rc(int b, int& R, int& C) { const int st = b / 1024, sb = b % 1024, swz = sb ^ (((sb >> 9) & 1) << 5); R = (st >> 1) * 16 + swz / 64; C = (st & 1) * 32 + (swz % 64) / 2; }
__host__ __device__ __forceinline__ int perm32(int rho) { const int n = rho >> 4, i = rho & 15; return 8 * (i >> 2) + 4 * n + (i & 3); }

struct Unit { const char* a; const char* b; int pm, pn, z; };
struct Gemm { int lda, ldb, K; size_t kstepA, kstepB, hstepA, hstepB; };
__device__ __forceinline__ Gemm gemm_rowmajor(int lda, int ldb, int K) { return Gemm{lda, ldb, K, (size_t)(BK * 2), (size_t)(BK * 2), (size_t)HALF * lda * 2, (size_t)HALF * ldb * 2}; }

struct TileSched {
    int nM, nN, per, nwg, G, c, wgm = WGM, pm0 = 0, pn0 = 0; const char* A; const char* B; size_t a_tile, b_tile, a_z, b_z;
    __device__ void init(int nM_, int nN_, int nZ_, int G_, int c_, const void* A_, const void* B_, size_t a_tile_, size_t b_tile_, size_t a_z_, size_t b_z_) {
        nM = nM_; nN = nN_; per = nM_ * nN_; nwg = per * nZ_; G = G_; c = c_; A = (const char*)A_; B = (const char*)B_; a_tile = a_tile_; b_tile = b_tile_; a_z = a_z_; b_z = b_z_; }
    __device__ bool next(int i, Unit& u) const {
        const long L = (long)i * G + c; if (L >= nwg) return false;
        int wgid = (int)L; { const int q = nwg / NXCD, r = nwg % NXCD, xcd = wgid % NXCD, off = wgid / NXCD; wgid = (xcd < r ? xcd * (q + 1) : r * (q + 1) + (xcd - r) * q) + off; }
        const int z = wgid / per, w = wgid % per;
        const int nig = wgm * nN, gid = w / nig, fm = gid * wgm, gsz = (nM - fm) < wgm ? (nM - fm) : wgm;
        u.pm = fm + ((w % nig) % gsz); u.pn = (w % nig) / gsz; u.z = z;
        u.a = A + (size_t)z * a_z + (size_t)u.pm * a_tile; u.b = B + (size_t)z * b_z + (size_t)u.pn * b_tile; u.pm += pm0; u.pn += pn0; return true;
    }
};
struct QkvSched {
    TileSched kvp, smp, plain; bool split; int i0, i1;
    __device__ void init(int G, int c, const bf16_t* Hm, const bf16_t* W, int i0_, int i1_) {
        const size_t tb = (size_t)256 * DM * 2; split = (G == 256); i0 = i0_; i1 = i1_;
        plain.init(64, 16, 1, G, c, Hm, W + (size_t)8 * 256 * DM, tb, tb, 0, 0); plain.pn0 = 8;
        kvp.init(32, 16, 1, G, c, Hm, W + (size_t)8 * 256 * DM, tb, tb, 0, 0); kvp.pn0 = 8;
        smp.init(32, 16, 1, G, c, Hm + (size_t)32 * 256 * DM, W + (size_t)8 * 256 * DM, tb, tb, 0, 0); smp.pm0 = 32; smp.pn0 = 8;
    }
    __device__ bool next(int i_, Unit& u) const {
        const int i = i_ + i0; if (i >= i1) return false;
        if (!split) return plain.next(i, u);
        if (i < 2) return kvp.next(i, u);
        return smp.next(i - 2, u);
    }
};

__device__ __forceinline__ unsigned cvt_pk_bf16(float lo, float hi) { unsigned r; asm volatile("v_cvt_pk_bf16_f32 %0, %1, %2" : "=v"(r) : "v"(lo), "v"(hi)); return r; }

__device__ __forceinline__ void store_tile_bf16(const f32x4 (&acc)[2][2][4][2], bf16_t* base, size_t ldc, int wr, int wc, int fr, int fq) {
    bf16_t* p0 = base + (size_t)(wr * 64 + fr) * ldc + wc * 32 + 8 * fq;
#pragma unroll
    for (int ai = 0; ai < 2; ++ai)
#pragma unroll
        for (int m = 0; m < 4; ++m) { bf16_t* rowp = p0 + (size_t)(ai * HALF + m * 16) * ldc;
#pragma unroll
            for (int bj = 0; bj < 2; ++bj) { const f32x4 v0 = acc[ai][bj][m][0], v1 = acc[ai][bj][m][1];
                u32x4 w; w.x = cvt_pk_bf16(v0[0], v0[1]); w.y = cvt_pk_bf16(v0[2], v0[3]); w.z = cvt_pk_bf16(v1[0], v1[1]); w.w = cvt_pk_bf16(v1[2], v1[3]);
                *(u32x4*)(rowp + bj * HALF) = w; } }
}

struct EpiQKV {
    static constexpr bool PERM = true;
    bf16_t* QKV; float* outkv;
    __device__ __forceinline__ void operator()(const f32x4 (&acc)[2][2][4][2], const Unit& u, int wr, int wc, int fr, int fq) const {
        const int t = u.pn >> 3, colt = (u.pn & 7) * 256;
        bf16_t* base = QKV + (size_t)t * NTOK * DATT + (size_t)(u.pm * 256) * DATT + colt;
        store_tile_bf16(acc, base, DATT, wr, wc, fr, fq);
        if (u.pm < 32 && t >= 1) {
            float* p0 = outkv + (size_t)(t - 1) * NPROMPT * DATT + (size_t)(u.pm * 256 + wr * 64 + fr) * DATT + colt + wc * 32 + 8 * fq;
#pragma unroll
            for (int ai = 0; ai < 2; ++ai)
#pragma unroll
                for (int m = 0; m < 4; ++m) { float* rowp = p0 + (size_t)(ai * HALF + m * 16) * DATT;
#pragma unroll
                    for (int bj = 0; bj < 2; ++bj) { __builtin_nontemporal_store(acc[ai][bj][m][0], (f32x4*)(rowp + bj * HALF)); __builtin_nontemporal_store(acc[ai][bj][m][1], (f32x4*)(rowp + bj * HALF + 4)); } }
        }
    }
};
struct EpiUT {
    static constexpr bool PERM = true; bf16_t* UT;
    __device__ __forceinline__ void operator()(const f32x4 (&acc)[2][2][4][2], const Unit& u, int wr, int wc, int fr, int fq) const {
        store_tile_bf16(acc, UT + (size_t)(u.pm * 256) * NTOK + u.pn * 256, NTOK, wr, wc, fr, fq); }
};
__device__ __forceinline__ void store_half_bf16(const f32x4 (&a)[2][4][2], bf16_t* base, long rstride, int skip_r, int wr, int wc, int fr, int fq) {
#pragma unroll
    for (int m = 0; m < 4; ++m) { const int r = wr * 64 + m * 16 + fr; bf16_t* rowp = base + (long)r * rstride + wc * 32 + 8 * fq;
        if (r != skip_r) {
#pragma unroll
            for (int bj = 0; bj < 2; ++bj) { const f32x4 v0 = a[bj][m][0], v1 = a[bj][m][1];
                u32x4 w; w.x = cvt_pk_bf16(v0[0], v0[1]); w.y = cvt_pk_bf16(v0[2], v0[3]); w.z = cvt_pk_bf16(v1[0], v1[1]); w.w = cvt_pk_bf16(v1[2], v1[3]);
                *(u32x4*)(rowp + bj * HALF) = w; } } }
}
struct EpiY2 {
    static constexpr bool PERM = true; bf16_t* Y2; int Th, row_base;
    __device__ __forceinline__ void operator()(const f32x4 (&acc)[2][2][4][2], const Unit& u, int wr, int wc, int fr, int fq) const {
        const int g = u.pn >> 1, c0 = (u.pn & 1) * 256;
#pragma unroll
        for (int ai = 0; ai < 2; ++ai) { const int m0 = u.pm * 256 + ai * HALF, cs = m0 / Th, kt0 = m0 % Th;
            store_half_bf16(acc[ai], Y2 + (size_t)(row_base + u.z * Th + kt0) * DM + g * 1024 + cs * 512 + c0, DM, -1, wr, wc, fr, fq); }
    }
};
struct EpiF2x {
    static constexpr bool PERM = true; bf16_t* MIX;
    __device__ __forceinline__ void operator()(const f32x4 (&acc)[2][2][4][2], const Unit& u, int wr, int wc, int fr, int fq) const {
        const int mir = u.pn >> 1, c0 = (u.pn & 1) * 256;
#pragma unroll
        for (int ai = 0; ai < 2; ++ai) { const int R0 = u.pm * 256 + ai * HALF; int T, tok0, kt0;
            if (R0 < 4096) { T = 256; tok0 = (R0 >> 7) * 256; kt0 = 0; } else { const int Rp = R0 - 4096; T = 2048; tok0 = NPROMPT + (Rp >> 10) * 2048; kt0 = Rp & 1023; }
            const int tok = tok0 + (mir ? T - kt0 : kt0);
            store_half_bf16(acc[ai], MIX + (size_t)tok * DM + DATT + u.z * 512 + c0, mir ? -(long)DM : (long)DM, kt0 == 0 ? 0 : -1, wr, wc, fr, fq); }
    }
};
struct EpiDelta {
    static constexpr bool PERM = true;
    bf16_t* Dl; const float* gate;
    __device__ __forceinline__ void operator()(const f32x4 (&acc)[2][2][4][2], const Unit& u, int wr, int wc, int fr, int fq) const {
        const int bidx = u.pm < 32 ? 0 : 1 + ((u.pm - 32) >> 3);
        const int col0 = u.pn * 256 + wc * 32 + 8 * fq;
        const float* gp = gate + (size_t)bidx * MODW + col0;
        f32x4 gv[2][2];
#pragma unroll
        for (int bj = 0; bj < 2; ++bj)
#pragma unroll
            for (int n = 0; n < 2; ++n) gv[bj][n] = *(const f32x4*)(gp + bj * HALF + 4 * n);
        bf16_t* p0 = Dl + (size_t)(u.pm * 256 + wr * 64 + fr) * DM + col0;
#pragma unroll
        for (int ai = 0; ai < 2; ++ai)
#pragma unroll
            for (int m = 0; m < 4; ++m) { bf16_t* rowp = p0 + (size_t)(ai * HALF + m * 16) * DM;
#pragma unroll
                for (int bj = 0; bj < 2; ++bj) { const f32x4 v0 = acc[ai][bj][m][0] * gv[bj][0], v1 = acc[ai][bj][m][1] * gv[bj][1];
                    u32x4 w; w.x = cvt_pk_bf16(v0[0], v0[1]); w.y = cvt_pk_bf16(v0[2], v0[3]); w.z = cvt_pk_bf16(v1[0], v1[1]); w.w = cvt_pk_bf16(v1[2], v1[3]);
                    *(u32x4*)(rowp + bj * HALF) = w; } }
    }
};
struct EpiSwiglu {
    static constexpr bool PERM = true; bf16_t* ACT;
    static __device__ __forceinline__ float sw(float g, float u) { return g * __builtin_amdgcn_rcpf(1.0f + __builtin_amdgcn_exp2f(-1.4426950408889634f * g)) * u; }
    __device__ __forceinline__ void operator()(const f32x4 (&acc)[2][2][4][2], const Unit& u, int wr, int wc, int fr, int fq) const {
        bf16_t* p0 = ACT + ((size_t)(u.pm * (DFF / 64) + u.pn * 2 + (wc >> 1)) * 256 + wr * 64 + fr) * 64 + (wc & 1) * 32 + 8 * fq;
#pragma unroll
        for (int ai = 0; ai < 2; ++ai)
#pragma unroll
            for (int m = 0; m < 4; ++m) { const f32x4 g0 = acc[ai][0][m][0], g1 = acc[ai][0][m][1], u0 = acc[ai][1][m][0], u1 = acc[ai][1][m][1];
                u32x4 w; w.x = cvt_pk_bf16(sw(g0[0], u0[0]), sw(g0[1], u0[1])); w.y = cvt_pk_bf16(sw(g0[2], u0[2]), sw(g0[3], u0[3]));
                w.z = cvt_pk_bf16(sw(g1[0], u1[0]), sw(g1[1], u1[1])); w.w = cvt_pk_bf16(sw(g1[2], u1[2]), sw(g1[3], u1[3]));
                __builtin_nontemporal_store(w, (u32x4*)(p0 + (size_t)(ai * HALF + m * 16) * 64)); }
    }
};

__device__ __forceinline__ void wht8(float (&a)[8]) {
#pragma unroll
    for (int st = 1; st < 8; st <<= 1)
#pragma unroll
        for (int i = 0; i < 8; ++i) if (!(i & st)) { const float x = a[i], y = a[i | st]; a[i] = x + y; a[i | st] = x - y; }
#pragma unroll
    for (int i = 0; i < 8; ++i) a[i] *= 0.35355339059327373f;
}
struct EpiKV8 {
    static constexpr bool PERM = true; bf16_t* QKV; const float* sA; const float* sW;
    __device__ __forceinline__ void operator()(const f32x4 (&acc)[2][2][4][2], const Unit& u, int wr, int wc, int fr, int fq) const {
        typedef int v4i_ __attribute__((ext_vector_type(4)));
        const int t = u.pn >> 3, colt = (u.pn & 7) * 256, row0 = u.pm * 256 + wr * 64 + fr, col0 = colt + wc * 32 + 8 * fq;
        const float* swp = sW + (size_t)(u.pn - 8) * 256 + wc * 32 + 8 * fq;
        f32x4 sc[2][2];
#pragma unroll
        for (int bj = 0; bj < 2; ++bj)
#pragma unroll
            for (int n = 0; n < 2; ++n) sc[bj][n] = *(const f32x4*)(swp + bj * HALF + 4 * n);
        bf16_t* p0 = QKV + (size_t)t * NTOK * DATT + (size_t)row0 * DATT + col0;
#pragma unroll
        for (int ai = 0; ai < 2; ++ai)
#pragma unroll
            for (int m = 0; m < 4; ++m) { bf16_t* rowp = p0 + (size_t)(ai * HALF + m * 16) * DATT; const float sr = sA[row0 + ai * HALF + m * 16];
#pragma unroll
                for (int bj = 0; bj < 2; ++bj) { const v4i_ i0 = __builtin_bit_cast(v4i_, acc[ai][bj][m][0]), i1 = __builtin_bit_cast(v4i_, acc[ai][bj][m][1]); f32x4 v0, v1;
#pragma unroll
                    for (int e = 0; e < 4; ++e) { v0[e] = (float)i0[e] * (sr * sc[bj][0][e]); v1[e] = (float)i1[e] * (sr * sc[bj][1][e]); }
                    u32x4 w; w.x = cvt_pk_bf16(v0[0], v0[1]); w.y = cvt_pk_bf16(v0[2], v0[3]); w.z = cvt_pk_bf16(v1[0], v1[1]); w.w = cvt_pk_bf16(v1[2], v1[3]);
                    *(u32x4*)(rowp + bj * HALF) = w; } }
    }
};
struct EpiQ8 {
    static constexpr bool PERM = true; bf16_t* Q; const float* sA; const float* sW;
    __device__ __forceinline__ void operator()(const f32x4 (&acc)[2][2][4][2], const Unit& u, int wr, int wc, int fr, int fq) const {
        typedef int v4i_ __attribute__((ext_vector_type(4)));
        const int row0 = u.pm * 256 + wr * 64 + fr, col0 = u.pn * 256 + wc * 32 + 8 * fq;
        f32x4 sc[2][2];
#pragma unroll
        for (int bj = 0; bj < 2; ++bj)
#pragma unroll
            for (int n = 0; n < 2; ++n) sc[bj][n] = *(const f32x4*)(sW + col0 + bj * HALF + 4 * n);
        bf16_t* p0 = Q + (size_t)row0 * DATT + col0;
#pragma unroll
        for (int ai = 0; ai < 2; ++ai)
#pragma unroll
            for (int m = 0; m < 4; ++m) { bf16_t* rowp = p0 + (size_t)(ai * HALF + m * 16) * DATT; const float sr = sA[row0 + ai * HALF + m * 16];
#pragma unroll
                for (int bj = 0; bj < 2; ++bj) { const v4i_ i0 = __builtin_bit_cast(v4i_, acc[ai][bj][m][0]), i1 = __builtin_bit_cast(v4i_, acc[ai][bj][m][1]); f32x4 v0, v1;
#pragma unroll
                    for (int e = 0; e < 4; ++e) { v0[e] = (float)i0[e] * (sr * sc[bj][0][e]); v1[e] = (float)i1[e] * (sr * sc[bj][1][e]); }
                    u32x4 w; w.x = cvt_pk_bf16(v0[0], v0[1]); w.y = cvt_pk_bf16(v0[2], v0[3]); w.z = cvt_pk_bf16(v1[0], v1[1]); w.w = cvt_pk_bf16(v1[2], v1[3]);
                    *(u32x4*)(rowp + bj * HALF) = w; } }
    }
};
struct EpiUT8 {
    static constexpr bool PERM = true; bf16_t* UT; const float* sRow; const float* sCol;
    __device__ __forceinline__ void operator()(const f32x4 (&acc)[2][2][4][2], const Unit& u, int wr, int wc, int fr, int fq) const {
        typedef int v4i_ __attribute__((ext_vector_type(4)));
        const int row0 = u.pm * 256 + wr * 64 + fr, col0 = u.pn * 256 + wc * 32 + 8 * fq;
        f32x4 sc[2][2];
#pragma unroll
        for (int bj = 0; bj < 2; ++bj)
#pragma unroll
            for (int n = 0; n < 2; ++n) sc[bj][n] = *(const f32x4*)(sCol + col0 + bj * HALF + 4 * n);
        bf16_t* p0 = UT + (size_t)row0 * NTOK + col0;
#pragma unroll
        for (int ai = 0; ai < 2; ++ai)
#pragma unroll
            for (int m = 0; m < 4; ++m) { bf16_t* rowp = p0 + (size_t)(ai * HALF + m * 16) * NTOK; const float sr = sRow[row0 + ai * HALF + m * 16];
#pragma unroll
                for (int bj = 0; bj < 2; ++bj) { const v4i_ i0 = __builtin_bit_cast(v4i_, acc[ai][bj][m][0]), i1 = __builtin_bit_cast(v4i_, acc[ai][bj][m][1]); f32x4 v0, v1;
#pragma unroll
                    for (int e = 0; e < 4; ++e) { v0[e] = (float)i0[e] * (sr * sc[bj][0][e]); v1[e] = (float)i1[e] * (sr * sc[bj][1][e]); }
                    u32x4 w; w.x = cvt_pk_bf16(v0[0], v0[1]); w.y = cvt_pk_bf16(v0[2], v0[3]); w.z = cvt_pk_bf16(v1[0], v1[1]); w.w = cvt_pk_bf16(v1[2], v1[3]);
                    *(u32x4*)(rowp + bj * HALF) = w; } }
    }
};
struct EpiDelta8 {
    static constexpr bool PERM = true; bf16_t* Dl; const float* gate; const float* sA; const float* sW;
    __device__ __forceinline__ void operator()(const f32x4 (&acc)[2][2][4][2], const Unit& u, int wr, int wc, int fr, int fq) const {
        typedef int v4i_ __attribute__((ext_vector_type(4)));
        const int bidx = u.pm < 32 ? 0 : 1 + ((u.pm - 32) >> 3);
        const int col0 = u.pn * 256 + wc * 32 + 8 * fq;
        const float* gp = gate + (size_t)bidx * MODW + col0; const float* swp = sW + col0;
        f32x4 gv[2][2];
#pragma unroll
        for (int bj = 0; bj < 2; ++bj)
#pragma unroll
            for (int n = 0; n < 2; ++n) gv[bj][n] = *(const f32x4*)(gp + bj * HALF + 4 * n) * *(const f32x4*)(swp + bj * HALF + 4 * n);
        bf16_t* p0 = Dl + (size_t)(u.pm * 256 + wr * 64 + fr) * DM + col0; const float* sap = sA + (size_t)u.pm * 256 + wr * 64 + fr;
#pragma unroll
        for (int ai = 0; ai < 2; ++ai)
#pragma unroll
            for (int m = 0; m < 4; ++m) { bf16_t* rowp = p0 + (size_t)(ai * HALF + m * 16) * DM; const float sa = sap[ai * HALF + m * 16];
#pragma unroll
                for (int bj = 0; bj < 2; ++bj) { const v4i_ i0 = __builtin_bit_cast(v4i_, acc[ai][bj][m][0]), i1 = __builtin_bit_cast(v4i_, acc[ai][bj][m][1]); f32x4 v0, v1;
#pragma unroll
                    for (int e = 0; e < 4; ++e) { v0[e] = (float)i0[e] * (sa * gv[bj][0][e]); v1[e] = (float)i1[e] * (sa * gv[bj][1][e]); }
                    u32x4 w; w.x = cvt_pk_bf16(v0[0], v0[1]); w.y = cvt_pk_bf16(v0[2], v0[3]); w.z = cvt_pk_bf16(v1[0], v1[1]); w.w = cvt_pk_bf16(v1[2], v1[3]);
                    *(u32x4*)(rowp + bj * HALF) = w; } }
    }
};
struct EpiSwiglu8 {
    static constexpr bool PERM = true; bf16_t* ACT; const float* sA; const float* sW; unsigned* rowmax;
    __device__ __forceinline__ void operator()(const f32x4 (&acc)[2][2][4][2], const Unit& u, int wr, int wc, int fr, int fq) const {
        typedef int v4i_ __attribute__((ext_vector_type(4)));
        bf16_t* p0 = ACT + ((size_t)(u.pm * (DFF / 64) + u.pn * 2 + (wc >> 1)) * 256 + wr * 64 + fr) * 64 + (wc & 1) * 32 + 8 * fq;
        const float* swp = sW + (size_t)u.pn * 256 + wc * 32 + 8 * fq;
        const f32x4 sg0 = *(const f32x4*)swp, sg1 = *(const f32x4*)(swp + 4), su0 = *(const f32x4*)(swp + HALF), su1 = *(const f32x4*)(swp + HALF + 4);
        const int row0 = u.pm * 256 + wr * 64 + fr; const float* sap = sA + row0;
#pragma unroll
        for (int ai = 0; ai < 2; ++ai)
#pragma unroll
            for (int m = 0; m < 4; ++m) { const float sa = sap[ai * HALF + m * 16];
                const v4i_ ig0 = __builtin_bit_cast(v4i_, acc[ai][0][m][0]), ig1 = __builtin_bit_cast(v4i_, acc[ai][0][m][1]), iu0 = __builtin_bit_cast(v4i_, acc[ai][1][m][0]), iu1 = __builtin_bit_cast(v4i_, acc[ai][1][m][1]);
                float a[8];
#pragma unroll
                for (int e = 0; e < 4; ++e) { a[e] = EpiSwiglu::sw((float)ig0[e] * (sa * sg0[e]), (float)iu0[e] * (sa * su0[e])); a[4 + e] = EpiSwiglu::sw((float)ig1[e] * (sa * sg1[e]), (float)iu1[e] * (sa * su1[e])); }
                wht8(a);
                u32x4 w; w.x = cvt_pk_bf16(a[0], a[1]); w.y = cvt_pk_bf16(a[2], a[3]); w.z = cvt_pk_bf16(a[4], a[5]); w.w = cvt_pk_bf16(a[6], a[7]);
                __builtin_nontemporal_store(w, (u32x4*)(p0 + (size_t)(ai * HALF + m * 16) * 64));
                float mx = fmaxf(fmaxf(fmaxf(fabsf(a[0]), fabsf(a[1])), fmaxf(fabsf(a[2]), fabsf(a[3]))), fmaxf(fmaxf(fabsf(a[4]), fabsf(a[5])), fmaxf(fabsf(a[6]), fabsf(a[7]))));
                mx = fmaxf(mx, __shfl_xor(mx, 16)); mx = fmaxf(mx, __shfl_xor(mx, 32));
                if (fq == 0) __hip_atomic_fetch_max(rowmax + row0 + ai * HALF + m * 16, cvt_pk_bf16(mx, mx) << 16, __ATOMIC_RELAXED, __HIP_MEMORY_SCOPE_AGENT); }
    }
};

template <class Epi, class Sched, bool ALIGN_EPI, bool I8 = false>
__device__ __forceinline__ void gemm_phase(PG8_LAS unsigned char* lds, const Gemm g, const Sched& S, const Epi& E) {
    const int tid = threadIdx.x, wid = __builtin_amdgcn_readfirstlane(tid >> 6), lane = tid & 63, wr = wid >> 2, wc = wid & 3, fr = lane & 15, fq = lane >> 4;
    const int K = g.K, nt = K / BK;
    unsigned voffA[2], voffB[2];
#pragma unroll
    for (int i = 0; i < 2; ++i) { int R, C; stage_rc(tid * 16 + i * 8192, R, C); const int Rb = Epi::PERM ? ((R & ~31) + perm32(R & 31)) : R;
        voffA[i] = (unsigned)(R * g.lda + C) * 2u; voffB[i] = (unsigned)(Rb * g.ldb + C) * 2u; }
    const size_t kstepA = g.kstepA, kstepB = g.kstepB, hstepA = g.hstepA, hstepB = g.hstepB;
    const unsigned ldsw = (unsigned)wid * 1024u;
    const int aoff = lds_byte(wr * 64 + fr, fq * 8), boff = lds_byte(wc * 32 + fr, fq * 8);
#define PG8_SA(b, h) (((b) * 2 + (h)) * HTB)
#define PG8_SB(b, h) ((4 + (b) * 2 + (h)) * HTB)
#define PG8_STAGE(bufoff, gbase, voff) do { _Pragma("unroll") for (int _i = 0; _i < 2; ++_i) \
        __builtin_amdgcn_global_load_lds((const unsigned*)((const char*)(gbase) + (voff)[_i]), (PG8_LAS unsigned*)(lds + (bufoff) + ldsw + _i * 8192), 16, 0, 0); } while (0)
#define PG8_STAGEB(bufoff, gbase, voff) do { _Pragma("unroll") for (int _i = 0; _i < 2; ++_i) \
        __builtin_amdgcn_global_load_lds((const unsigned*)((const char*)(gbase) + (voff)[_i]), (PG8_LAS unsigned*)(lds + (bufoff) + ldsw + _i * 8192), 16, 0, 0); } while (0)
#define PG8_LDA(dst, b, h) do { _Pragma("unroll") for (int m = 0; m < 4; ++m) _Pragma("unroll") for (int k = 0; k < 2; ++k) dst[m][k] = *(const PG8_LAS bf16x8*)(lds + PG8_SA(b, h) + aoff + m * 2048 + k * 1024); } while (0)
#define PG8_LDB(dst, b, h) do { _Pragma("unroll") for (int n = 0; n < 2; ++n) _Pragma("unroll") for (int k = 0; k < 2; ++k) dst[n][k] = *(const PG8_LAS bf16x8*)(lds + PG8_SB(b, h) + boff + n * 2048 + k * 1024); } while (0)
#define PG8_MMA(ai, bj, At, Bt) do { __builtin_amdgcn_s_setprio(1); _Pragma("unroll") for (int m = 0; m < 4; ++m) _Pragma("unroll") for (int n = 0; n < 2; ++n) _Pragma("unroll") for (int k = 0; k < 2; ++k) { \
        if constexpr (I8) { typedef int v4i_ __attribute__((ext_vector_type(4))); \
            acc[ai][bj][m][n] = __builtin_bit_cast(f32x4, __builtin_amdgcn_mfma_i32_16x16x64_i8(__builtin_bit_cast(v4i_, Bt[n][k]), __builtin_bit_cast(v4i_, At[m][k]), __builtin_bit_cast(v4i_, acc[ai][bj][m][n]), 0, 0, 0)); } \
        else acc[ai][bj][m][n] = __builtin_amdgcn_mfma_f32_16x16x32_bf16(Bt[n][k], At[m][k], acc[ai][bj][m][n], 0, 0, 0); } __builtin_amdgcn_s_setprio(0); } while (0)
#define PG8_WAIT_V(n) asm volatile("s_waitcnt vmcnt(" #n ")" ::: "memory")
#define PG8_WAIT_L(n) asm volatile("s_waitcnt lgkmcnt(" #n ")" ::: "memory")
#define PG8_BAR __builtin_amdgcn_s_barrier()
#define PG8_SCHED __builtin_amdgcn_sched_barrier(0)
    Unit cur, nxt; int ui = 0;
    if (!S.next(0, cur)) return;
    f32x4 acc[2][2][4][2];
#pragma unroll
    for (int a = 0; a < 2; ++a)
#pragma unroll
        for (int b = 0; b < 2; ++b)
#pragma unroll
            for (int m = 0; m < 4; ++m)
#pragma unroll
                for (int n = 0; n < 2; ++n) acc[a][b][m][n] = (f32x4){0.f, 0.f, 0.f, 0.f};
    bf16x8 At[4][2], B0[2][2], B1[2][2];
    const char* cA = cur.a; const char* cB = cur.b;
    PG8_STAGEB(PG8_SB(0, 0), cB, voffB); PG8_STAGEB(PG8_SB(0, 1), cB + hstepB, voffB); PG8_STAGE(PG8_SA(0, 0), cA, voffA); PG8_STAGE(PG8_SA(0, 1), cA + hstepA, voffA);
    if (wr == 1) PG8_BAR;
    PG8_WAIT_V(2); PG8_BAR;
    PG8_STAGEB(PG8_SB(1, 0), cB + kstepB, voffB); PG8_STAGE(PG8_SA(1, 0), cA + kstepA, voffA); PG8_STAGEB(PG8_SB(1, 1), cB + hstepB + kstepB, voffB);
    PG8_WAIT_V(6); PG8_BAR;
    for (;;) {
        const bool has_next = S.next(ui + 1, nxt);
        const char* nA = has_next ? nxt.a : cA; const char* nB = has_next ? nxt.b : cB;
        for (int t = 0; t < nt; t += 2) {
            const bool last = (t == nt - 2);
            const char* a1 = cA + (size_t)(t + 1) * kstepA;
            const char* a2 = last ? nA : cA + (size_t)(t + 2) * kstepA; const char* b2 = last ? nB : cB + (size_t)(t + 2) * kstepB;
            const char* a3 = a2 + kstepA; const char* b3 = b2 + kstepB;
            PG8_LDB(B0, 0, 0); PG8_LDB(B1, 0, 1); PG8_SCHED; PG8_LDA(At, 0, 0); PG8_STAGE(PG8_SA(1, 1), a1 + hstepA, voffA);
            PG8_WAIT_V(8); PG8_WAIT_L(0); PG8_BAR; PG8_MMA(0, 0, At, B0); PG8_MMA(0, 1, At, B1); PG8_BAR; PG8_SCHED;
            PG8_LDA(At, 0, 1); PG8_STAGEB(PG8_SB(0, 0), b2, voffB); PG8_STAGEB(PG8_SB(0, 1), b2 + hstepB, voffB); PG8_STAGE(PG8_SA(0, 0), a2, voffA);
            PG8_WAIT_V(8); PG8_WAIT_L(0); PG8_BAR; PG8_MMA(1, 0, At, B0); PG8_MMA(1, 1, At, B1); PG8_BAR; PG8_SCHED;
            PG8_LDB(B0, 1, 0); PG8_LDB(B1, 1, 1); PG8_SCHED; PG8_LDA(At, 1, 0); PG8_STAGE(PG8_SA(0, 1), a2 + hstepA, voffA);
            PG8_WAIT_V(8); PG8_WAIT_L(0); PG8_BAR; PG8_MMA(0, 0, At, B0); PG8_MMA(0, 1, At, B1); PG8_BAR; PG8_SCHED;
            PG8_LDA(At, 1, 1); PG8_STAGEB(PG8_SB(1, 0), b3, voffB); PG8_STAGEB(PG8_SB(1, 1), b3 + hstepB, voffB); PG8_STAGE(PG8_SA(1, 0), a3, voffA);
            PG8_WAIT_V(8); PG8_WAIT_L(0); PG8_BAR; PG8_MMA(1, 0, At, B0); PG8_MMA(1, 1, At, B1); PG8_BAR; PG8_SCHED;
        }
        if constexpr (ALIGN_EPI) { if (wr == 0) PG8_BAR; }
        E(acc, cur, wr, wc, fr, fq);
        if (!has_next) break;
#pragma unroll
        for (int a = 0; a < 2; ++a)
#pragma unroll
            for (int b = 0; b < 2; ++b)
#pragma unroll
                for (int m = 0; m < 4; ++m)
#pragma unroll
                    for (int n = 0; n < 2; ++n) acc[a][b][m][n] = (f32x4){0.f, 0.f, 0.f, 0.f};
        cur = nxt; cA = nA; cB = nB; ++ui;
        if constexpr (ALIGN_EPI) { if (wr == 1) PG8_BAR; }
    }
    PG8_WAIT_V(0);
    if constexpr (!ALIGN_EPI) { if (wr == 0) PG8_BAR; }
    PG8_BAR;
#undef PG8_SA
#undef PG8_SB
#undef PG8_STAGE
#undef PG8_STAGEB
#undef PG8_LDA
#undef PG8_LDB
#undef PG8_MMA
#undef PG8_WAIT_V
#undef PG8_WAIT_L
#undef PG8_BAR
#undef PG8_SCHED
}
}

namespace att {
using bf16x8 = __attribute__((ext_vector_type(8))) short;
using s16x4  = __attribute__((ext_vector_type(4))) short;
using f32x16 = __attribute__((ext_vector_type(16))) float;
using u32x4  = __attribute__((ext_vector_type(4))) unsigned;
constexpr int D = 128, NW = 8, QBLK = 32, KVBLK = 64;
constexpr float SCALE = 0.088388347648318440f;
constexpr float THR = 8.f;
constexpr int LDQ = DATT, LDK = DATT, LDO = DM;
constexpr size_t SHM_V = KVBLK * D * 2, SHM_K = KVBLK * D * 2;
constexpr int OFF_WS = 2 * SHM_V + 2 * SHM_K, OFF_TAB = OFF_WS + NW * 64 * 4, OFF_OST = OFF_TAB + 15 * 128 * 4, OST_PITCH = 272, OST_WAVE = 32 * OST_PITCH, SHM_ATTN = OFF_OST + NW * OST_WAVE;
constexpr float NEG = -1e30f, M_INIT = -1e4f;
#define KSWZ(row, colB) ((row) * 256 + ((colB) ^ (((row) & 7) << 4)))
#define SBAR() __builtin_amdgcn_sched_barrier(0)
__device__ __forceinline__ int crow(int r, int hi) { return (r & 3) + 8 * (r >> 2) + 4 * hi; }
__device__ __forceinline__ unsigned cvtpk(float lo, float hi) { unsigned r; asm volatile("v_cvt_pk_bf16_f32 %0, %1, %2" : "=v"(r) : "v"(lo), "v"(hi)); return r; }

__device__ __forceinline__ void partialSM(f32x16& p0, f32x16& p1, float& m_reg, float& mn, float& alpha) {
  constexpr float C = SCALE * 1.4426950408889634f;
  float pmax = p0[0];
#pragma unroll
  for (int r = 1; r < 16; ++r) pmax = fmaxf(pmax, p0[r]);
#pragma unroll
  for (int r = 0; r < 16; ++r) pmax = fmaxf(pmax, p1[r]);
  { auto rr = __builtin_amdgcn_permlane32_swap(__float_as_uint(pmax), __float_as_uint(pmax), false, false);
    pmax = fmaxf(__uint_as_float(rr[0]), __uint_as_float(rr[1])); }
  if (__builtin_expect(__all(pmax - m_reg <= THR / SCALE), 1)) { mn = m_reg; alpha = 1.f; }
  else { mn = fmaxf(m_reg, pmax); alpha = __builtin_amdgcn_exp2f((m_reg - mn) * C); m_reg = mn; }
  float mnC = -mn * C;
#pragma unroll
  for (int r = 0; r < 16; ++r) p0[r] = fmaf(p0[r], C, mnC);
#pragma unroll
  for (int r = 0; r < 16; ++r) p1[r] = fmaf(p1[r], C, mnC);
#pragma unroll
  for (int r = 0; r < 16; ++r) p0[r] = __builtin_amdgcn_exp2f(p0[r]);
}
__device__ __forceinline__ void finishSM(f32x16& p0, f32x16& p1, float alpha, float& l_reg, bf16x8& pa0, bf16x8& pa1, bf16x8& pa2, bf16x8& pa3) {
#pragma unroll
  for (int r = 0; r < 16; ++r) p1[r] = __builtin_amdgcn_exp2f(p1[r]);
  float ps = 0;
#pragma unroll
  for (int r = 0; r < 16; ++r) ps += p0[r];
#pragma unroll
  for (int r = 0; r < 16; ++r) ps += p1[r];
  { auto rr = __builtin_amdgcn_permlane32_swap(__float_as_uint(ps), __float_as_uint(ps), false, false);
    ps = __uint_as_float(rr[0]) + __uint_as_float(rr[1]); }
  l_reg = l_reg * alpha + ps;
#define PK4(P, BASE, OUT) do { unsigned a0 = cvtpk(P[BASE + 0], P[BASE + 1]), a1 = cvtpk(P[BASE + 2], P[BASE + 3]);   \
    unsigned b0 = cvtpk(P[BASE + 4], P[BASE + 5]), b1 = cvtpk(P[BASE + 6], P[BASE + 7]);                              \
    auto r0 = __builtin_amdgcn_permlane32_swap(a0, b0, false, false); auto r1 = __builtin_amdgcn_permlane32_swap(a1, b1, false, false); \
    u32x4 w = {r0[0], r1[0], r0[1], r1[1]}; OUT = *reinterpret_cast<bf16x8*>(&w); } while (0)
  PK4(p0, 0, pa0); PK4(p0, 8, pa1); PK4(p1, 0, pa2); PK4(p1, 8, pa3);
#undef PK4
}
__device__ __forceinline__ void qkt(f32x16& p0, f32x16& p1, const char* Ks, const bf16x8* qr, int r32, int hi) {
  p0 = f32x16{}; p1 = f32x16{};
#pragma unroll
  for (int d0 = 0; d0 < 8; ++d0) { int cb = (d0 * 16 + hi * 8) * 2;
    bf16x8 b0 = *reinterpret_cast<const bf16x8*>(Ks + KSWZ(r32, cb));
    bf16x8 b1 = *reinterpret_cast<const bf16x8*>(Ks + KSWZ(32 + r32, cb));
    p0 = __builtin_amdgcn_mfma_f32_32x32x16_bf16(b0, qr[d0], p0, 0, 0, 0);
    p1 = __builtin_amdgcn_mfma_f32_32x32x16_bf16(b1, qr[d0], p1, 0, 0, 0); }
}
__device__ __forceinline__ int v_st(int k, int c) { const int kk = (k & ~0xC) | ((k & 4) << 1) | ((k & 8) >> 1); return ((kk >> 3) * 4 + (c >> 5)) * 512 + ((kk & 7) * 32 + (c & 31)) * 2; }
__device__ __forceinline__ int v_rd_base(int lane) { return ((lane & 3) << 3) | (((lane >> 2) & 3) << 6) | (((lane >> 4) & 1) << 5) | (((lane >> 5) & 1) << 8); }
constexpr int v_rd_off(int d0, int ks, int half) { return d0 * 512 + ks * 4096 + half * 2048; }
template <int OFF> __device__ __forceinline__ s16x4 tr_read(int vb) {
  s16x4 r; asm volatile("ds_read_b64_tr_b16 %0, %1 offset:%2" : "=&v"(r) : "v"(vb), "i"(OFF) : "memory"); return r;
}
template <int D0> __device__ __forceinline__ void pv_one(f32x16& od, int vb, bf16x8 pa0, bf16x8 pa1, bf16x8 pa2, bf16x8 pa3) {
  const s16x4 l0 = tr_read<v_rd_off(D0, 0, 0)>(vb), h0 = tr_read<v_rd_off(D0, 0, 1)>(vb), l1 = tr_read<v_rd_off(D0, 1, 0)>(vb), h1 = tr_read<v_rd_off(D0, 1, 1)>(vb);
  const s16x4 l2 = tr_read<v_rd_off(D0, 2, 0)>(vb), h2 = tr_read<v_rd_off(D0, 2, 1)>(vb), l3 = tr_read<v_rd_off(D0, 3, 0)>(vb), h3 = tr_read<v_rd_off(D0, 3, 1)>(vb);
  asm volatile("s_waitcnt lgkmcnt(0)" ::: "memory"); SBAR();
#define PK(L, H) (bf16x8){L[0], L[1], L[2], L[3], H[0], H[1], H[2], H[3]}
  od = __builtin_amdgcn_mfma_f32_32x32x16_bf16(pa0, PK(l0, h0), od, 0, 0, 0);
  od = __builtin_amdgcn_mfma_f32_32x32x16_bf16(pa1, PK(l1, h1), od, 0, 0, 0);
  od = __builtin_amdgcn_mfma_f32_32x32x16_bf16(pa2, PK(l2, h2), od, 0, 0, 0);
  od = __builtin_amdgcn_mfma_f32_32x32x16_bf16(pa3, PK(l3, h3), od, 0, 0, 0);
#undef PK
}
__device__ __forceinline__ void pv_d0(f32x16* o, int vb, bf16x8 pa0, bf16x8 pa1, bf16x8 pa2, bf16x8 pa3) {
  pv_one<0>(o[0], vb, pa0, pa1, pa2, pa3); pv_one<1>(o[1], vb, pa0, pa1, pa2, pa3); pv_one<2>(o[2], vb, pa0, pa1, pa2, pa3); pv_one<3>(o[3], vb, pa0, pa1, pa2, pa3);
}

struct AttnUnit { const bf16* Q; const bf16* K0; const bf16* V0; const bf16* K1; const bf16* V1; bf16* O; const float* rpbh; int n0, n1, r0, kr0; };

template <bool NEIGH>
__device__ __forceinline__ void attn_unit(const AttnUnit& U, char* lds) {
  const int tid = threadIdx.x, wid = tid >> 6, lane = tid & 63, r32 = lane & 31, hi = lane >> 5;
  char* V_lds = lds; char* K_lds = lds + 2 * SHM_V;
  float* ws = (float*)(lds + OFF_WS) + wid * 64; float* li_l = ws; float* al_l = ws + 32;
  float* tab = (float*)(lds + OFF_TAB);
  __syncthreads();
  if (NEIGH) { for (int i = tid; i < 15 * 128; i += 512) { const int dr = i >> 7, dc = (i & 127) - 48; tab[i] = (dc >= 0 && dc < 31) ? U.rpbh[dr * 31 + dc] * (1.0f / SCALE) : 0.f; } }
  float m_reg = M_INIT, l_reg = 0; f32x16 o[4] = {}; bf16x8 qr[8];
  const bf16* Qw = U.Q + (long)(wid * QBLK + r32) * LDQ + hi * 8;
#pragma unroll
  for (int d0 = 0; d0 < 8; ++d0) qr[d0] = *reinterpret_cast<const bf16x8*>(Qw + d0 * 16);
  const int sr = tid >> 4, sc = (tid & 15) * 8, vst0 = v_st(sr, sc), vst1 = v_st(32 + sr, sc);
  const int vb0 = (int)(uintptr_t)V_lds + v_rd_base(lane);
  const int qrow = U.r0 + (wid >> 1), rs = min(max(qrow - 4, 0), 24), qc = (wid & 1) * 32 + r32, cs = min(max(qc - 8, 0), 48);
  struct { bf16x8 vs0, vs1, ks0, ks1; } sr_[2];
  const int n0 = U.n0, NT = U.n0 + U.n1;
#define KPTR(j) ((j) < n0 ? U.K0 + (long)(j) * KVBLK * LDK : U.K1 + (long)((j) - n0) * KVBLK * LDK)
#define VPTR(j) ((j) < n0 ? U.V0 + (long)(j) * KVBLK * LDK : U.V1 + (long)((j) - n0) * KVBLK * LDK)
#define SLOAD(i, j) do { const bf16* kp_ = KPTR(j); const bf16* vp_ = VPTR(j); \
    sr_[i].vs0 = *reinterpret_cast<const bf16x8*>(&vp_[(long)sr * LDK + sc]); sr_[i].vs1 = *reinterpret_cast<const bf16x8*>(&vp_[(long)(32 + sr) * LDK + sc]); \
    sr_[i].ks0 = *reinterpret_cast<const bf16x8*>(&kp_[(long)sr * LDK + sc]); sr_[i].ks1 = *reinterpret_cast<const bf16x8*>(&kp_[(long)(32 + sr) * LDK + sc]); } while (0)
#define SWRITE(b, i) do { *(bf16x8*)(V_lds + (b) * SHM_V + vst0) = sr_[i].vs0; *(bf16x8*)(V_lds + (b) * SHM_V + vst1) = sr_[i].vs1; int kc = sc * 2; \
    *(bf16x8*)(K_lds + (b) * SHM_K + KSWZ(sr, kc)) = sr_[i].ks0; *(bf16x8*)(K_lds + (b) * SHM_K + KSWZ(32 + sr, kc)) = sr_[i].ks1; } while (0)
#define SWAIT() asm volatile("s_waitcnt vmcnt(4)" ::: "memory")
#define RESC(a) do { if (__any((a) < 1.f)) { if (hi == 0) al_l[r32] = (a); asm volatile("s_waitcnt lgkmcnt(0)" ::: "memory"); \
    _Pragma("unroll") for (int d = 0; d < 4; ++d) _Pragma("unroll") for (int r = 0; r < 16; ++r) o[d][r] *= al_l[crow(r, hi)]; } } while (0)
#define BIASMASK(P0, P1, j) do { if (NEIGH && (j) < n0) { const int kr_ = U.kr0 + (j); \
    if ((unsigned)(kr_ - rs) < 8u) { const float* trow_ = tab + (kr_ - qrow + 7) * 128 + (63 - qc + 4 * hi); const int cb_ = 4 * hi - cs; \
      _Pragma("unroll") for (int r = 0; r < 16; ++r) { const int kc_ = (r & 3) + 8 * (r >> 2); \
        P0[r] = ((unsigned)(cb_ + kc_) < 16u) ? P0[r] + trow_[kc_] : NEG; \
        P1[r] = ((unsigned)(cb_ + kc_ + 32) < 16u) ? P1[r] + trow_[kc_ + 32] : NEG; \
        if ((r & 3) == 3) asm volatile("" ::: "memory"); } } \
    else { _Pragma("unroll") for (int r = 0; r < 16; ++r) { P0[r] = NEG; P1[r] = NEG; } } } } while (0)
  f32x16 pA0, pA1, pB0, pB1; float mnA, mnB, alA, alB; bf16x8 pa0, pa1, pa2, pa3;
  constexpr int SE = 0, SO = 1;
  SLOAD(SE, 0); asm volatile("s_waitcnt vmcnt(0)" ::: "memory"); SWRITE(0, SE); __syncthreads();
  qkt(pA0, pA1, K_lds, qr, r32, hi); BIASMASK(pA0, pA1, 0); partialSM(pA0, pA1, m_reg, mnA, alA);
  SLOAD(SO, 1); if (2 < NT) SLOAD(SE, 2);
  SWAIT(); SWRITE(1, SO); __syncthreads();
  for (int j = 1; j + 1 < NT; j += 2) {
    SBAR(); qkt(pB0, pB1, K_lds + SHM_K, qr, r32, hi);
    finishSM(pA0, pA1, alA, l_reg, pa0, pa1, pa2, pa3); SBAR();
    SLOAD(SO, j + 2); SBAR();
    pv_d0(o, vb0, pa0, pa1, pa2, pa3); BIASMASK(pB0, pB1, j); partialSM(pB0, pB1, m_reg, mnB, alB);
    __syncthreads(); SWAIT(); SWRITE(0, SE);
    RESC(alB); __syncthreads();
    SBAR(); qkt(pA0, pA1, K_lds, qr, r32, hi);
    finishSM(pB0, pB1, alB, l_reg, pa0, pa1, pa2, pa3); SBAR();
    if (j + 3 < NT) SLOAD(SE, j + 3); SBAR();
    pv_d0(o, vb0 + (int)SHM_V, pa0, pa1, pa2, pa3); BIASMASK(pA0, pA1, j + 1); partialSM(pA0, pA1, m_reg, mnA, alA);
    __syncthreads(); SWAIT(); SWRITE(1, SO);
    RESC(alA); __syncthreads();
  }
  SBAR(); qkt(pB0, pB1, K_lds + SHM_K, qr, r32, hi);
  finishSM(pA0, pA1, alA, l_reg, pa0, pa1, pa2, pa3); SBAR();
  pv_d0(o, vb0, pa0, pa1, pa2, pa3); BIASMASK(pB0, pB1, NT - 1); partialSM(pB0, pB1, m_reg, mnB, alB);
  __syncthreads(); RESC(alB);
  finishSM(pB0, pB1, alB, l_reg, pa0, pa1, pa2, pa3); SBAR();
  pv_d0(o, vb0 + (int)SHM_V, pa0, pa1, pa2, pa3);
  if (hi == 0) li_l[r32] = l_reg; asm volatile("s_waitcnt lgkmcnt(0)" ::: "memory");
  float rli[16];
#pragma unroll
  for (int r = 0; r < 16; ++r) rli[r] = __builtin_amdgcn_rcpf(li_l[crow(r, hi)]);
  char* ost = lds + OFF_OST + wid * OST_WAVE;
#pragma unroll
  for (int r = 0; r < 16; ++r) { const int orow = crow(r, hi);
#pragma unroll
    for (int d0 = 0; d0 < 4; ++d0) { const float v = o[d0][r] * rli[r]; *(bf16*)(ost + orow * OST_PITCH + (d0 * 32 + r32) * 2) = (bf16)(cvtpk(v, v) & 0xffffu); } }
  asm volatile("s_waitcnt lgkmcnt(0)" ::: "memory");
  { bf16* Ow = U.O + (long)(wid * QBLK + (lane >> 4)) * LDO + (lane & 15) * 8; const char* osr = ost + (lane >> 4) * OST_PITCH + (lane & 15) * 16;
#pragma unroll 1
    for (int i = 0; i < 8; ++i) { *(u32x4*)Ow = *(const u32x4*)osr; Ow += 4 * LDO; osr += 4 * OST_PITCH; } }
#undef KPTR
#undef VPTR
#undef SLOAD
#undef SWRITE
#undef SWAIT
#undef RESC
#undef BIASMASK
}
}
static_assert(att::SHM_ATTN <= LDSCTL_OFF, "attention LDS stays below the control words");

#define XB_TMO      128
#define XB_XCNT(j)  (256  + 64 * (j))
#define XB_XSUB(j)  (1280 + 64 * (j))
#define XB_XGEN(j)  (2304 + 64 * (j))
#define XB_TOP      3328
#define XB_TOPGEN   3392
#define XCD_BAR_WORDS 3456
#define XB_SPIN_CAP (1u << 18)
__device__ __forceinline__ unsigned xb_ld(unsigned* p)              { return __hip_atomic_load(p, __ATOMIC_RELAXED, __HIP_MEMORY_SCOPE_AGENT); }
__device__ __forceinline__ unsigned xb_add(unsigned* p, unsigned v) { return __hip_atomic_fetch_add(p, v, __ATOMIC_RELAXED, __HIP_MEMORY_SCOPE_AGENT); }
__device__ __forceinline__ unsigned xb_xcc_id() { return (unsigned)__builtin_amdgcn_s_getreg((3 << 11) | 20) & 0xFu; }
#define XB_SPIN(cond, bar) do { unsigned _sp = 0; while (cond) { __builtin_amdgcn_s_sleep(1); \
    if ((++_sp & 255u) == 0u) { if (xb_ld(&(bar)[XB_TMO])) break; if (_sp > XB_SPIN_CAP) { atomicAdd(&(bar)[XB_TMO], 1u); break; } } } } while (0)
struct XcdBarrier { unsigned* bar; unsigned x; volatile LAS unsigned* st; };
__device__ __forceinline__ XcdBarrier xcd_barrier_post(unsigned* bar, volatile LAS unsigned* st) {
    XcdBarrier b; b.bar = bar; b.x = xb_xcc_id(); b.st = st;
    if (threadIdx.x == 0) (void)xb_add(&bar[XB_XCNT(b.x)], 1u);
    return b;
}
__device__ __forceinline__ void xcd_barrier_complete(unsigned* bar, unsigned x, unsigned& nloc, unsigned& nx) {
    const unsigned G = gridDim.x * gridDim.y * gridDim.z;
    unsigned sum, cnt, mine, sp = 0u;
    for (;;) {
        sum = 0u; cnt = 0u; mine = 0u;
#pragma unroll
        for (unsigned j = 0; j < 16; ++j) { const unsigned c = xb_ld(&bar[XB_XCNT(j)]); sum += c; cnt += (c > 0u) ? 1u : 0u; mine = (j == x) ? c : mine; }
        if (sum == G) break;
        __builtin_amdgcn_s_sleep(1);
        if ((++sp & 255u) == 0u) { if (xb_ld(&bar[XB_TMO])) break; if (sp > XB_SPIN_CAP) { atomicAdd(&bar[XB_TMO], 1u); break; } }
    }
    nloc = mine > 0u ? mine : 1u; nx = cnt > 0u ? cnt : 1u;
}
__device__ __forceinline__ void xcd_barrier(const XcdBarrier& b) {
    asm volatile("s_waitcnt vmcnt(0)" ::: "memory");
    __syncthreads();
    if (threadIdx.x == 0) {
        unsigned* bar = b.bar;
        __builtin_amdgcn_s_waitcnt(0);
        unsigned nloc = b.st[0], nx = b.st[1];
        if (nloc == 0u) { xcd_barrier_complete(bar, b.x, nloc, nx); b.st[0] = nloc; b.st[1] = nx; }
        const unsigned old = xb_add(&bar[XB_XSUB(b.x)], 1u);
        const unsigned gen = old / nloc;
        if (old + 1u == (gen + 1u) * nloc) {
            __builtin_amdgcn_fence(__ATOMIC_RELEASE, "agent");
            asm volatile("s_waitcnt vmcnt(0)" ::: "memory");
            const unsigned og = xb_add(&bar[XB_TOP], 1u);
            const unsigned tg = og / nx;
            if (og + 1u == (tg + 1u) * nx) xb_add(&bar[XB_TOPGEN], 1u);
            else XB_SPIN(xb_ld(&bar[XB_TOPGEN]) == tg, bar);
            __builtin_amdgcn_fence(__ATOMIC_ACQUIRE, "agent");
            xb_add(&bar[XB_XGEN(b.x)], 1u);
            asm volatile("s_waitcnt vmcnt(0)" ::: "memory");
        } else {
            XB_SPIN(xb_ld(&bar[XB_XGEN(b.x)]) == gen, bar);
            __builtin_amdgcn_fence(__ATOMIC_ACQUIRE, "agent");
            asm volatile("s_waitcnt vmcnt(0)" ::: "memory");
        }
    }
    __syncthreads();
}

typedef float f32x4 __attribute__((ext_vector_type(4)));
__device__ __forceinline__ unsigned f2bf(float f) { unsigned u = __builtin_bit_cast(unsigned, f); return (u + 0x7fffu + ((u >> 16) & 1u)) >> 16; }
__device__ __forceinline__ unsigned pk2(float lo, float hi) { return f2bf(lo) | (f2bf(hi) << 16); }
__device__ __forceinline__ float wave_sum(float v) {
#pragma unroll
    for (int o = 1; o < 64; o <<= 1) v += __shfl_xor(v, o);
    return v;
}

__device__ __forceinline__ unsigned q8x4(float a, float b, float c, float d, float iv) {
    unsigned r = 0u;
    r = __builtin_amdgcn_cvt_pk_u8_f32(__builtin_rintf(a * iv + 128.0f), 0, r); r = __builtin_amdgcn_cvt_pk_u8_f32(__builtin_rintf(b * iv + 128.0f), 1, r);
    r = __builtin_amdgcn_cvt_pk_u8_f32(__builtin_rintf(c * iv + 128.0f), 2, r); r = __builtin_amdgcn_cvt_pk_u8_f32(__builtin_rintf(d * iv + 128.0f), 3, r);
    return r ^ 0x80808080u;
}
__device__ __forceinline__ f32x4 add_bf4(f32x4 v, v2u d) {
    v.x += __uint_as_float(d.x << 16); v.y += __uint_as_float(d.x & 0xffff0000u); v.z += __uint_as_float(d.y << 16); v.w += __uint_as_float(d.y & 0xffff0000u); return v; }

struct Args {
    const float *x_prompt, *x_sample, *cache_k, *cache_v, *c, *c_ctx, *w_ada, *b_ada, *norm1_g, *w_in, *rpb, *w_out, *norm2_g, *w_gate, *w_up, *w_down, *final_g;
    float* out; unsigned char* ws; int ph_lo, ph_hi;
};

struct TrItem { const float* W; bf16* WT; int N, k0, n0, drow0, dcol; unsigned ldT; bool nt; };
constexpr int TR_I_IN = 64 * 64, TR_I_OUT = 64 * 64, TR_I_G = 64 * 172, TR_I_D = 172 * 64, TR_NITEMS = TR_I_IN + TR_I_OUT + 2 * TR_I_G + TR_I_D;
__device__ __forceinline__ TrItem tr_decode(const Args& args, bf16* WinT, bf16* WoutT, bf16* WguT, bf16* WdT, int r) {
    TrItem t;
    if (r < TR_I_IN) { const int kb = r / 64, nb = 32 + r % 64; t.W = args.w_in;
        t.N = 8192; t.k0 = kb * 64; t.n0 = nb * 64; t.WT = WinT; t.ldT = DM; t.drow0 = nb * 64; t.dcol = t.k0; t.nt = false; return t; } r -= TR_I_IN;
    if (r < TR_I_OUT) { const int kb = r / 64, nb = r % 64; t.W = args.w_out; t.N = DM; t.k0 = kb * 64; t.n0 = nb * 64; t.WT = WoutT; t.ldT = DM; t.drow0 = nb * 64; t.dcol = t.k0; t.nt = true; return t; } r -= TR_I_OUT;
    if (r < 2 * TR_I_G) { const bool up = r >= TR_I_G; if (up) r -= TR_I_G; const int kb = r / 172, nb = r % 172, n0 = nb * 64;
        t.W = up ? args.w_up : args.w_gate; t.N = DFF; t.k0 = kb * 64; t.n0 = n0; t.WT = WguT; t.ldT = DM; t.drow0 = (n0 >> 7) * 256 + (n0 & 127) + (up ? 128 : 0); t.dcol = t.k0; t.nt = true; return t; } r -= 2 * TR_I_G;
    { const int kb = r / 64, nb = r % 64; t.W = args.w_down; t.N = DM; t.k0 = kb * 64; t.n0 = nb * 64; t.WT = WdT + ((size_t)((nb >> 2) * (DFF / 64) + kb) * 256 + (nb & 3) * 64) * 64; t.ldT = 64; t.drow0 = 0; t.dcol = 0; t.nt = false; return t; }
}
__device__ __forceinline__ void tr_load(const TrItem& t, f32x4 (&v)[16], int lane) {
    const int rr = lane >> 4, cc = (lane & 15) * 4;
    const GAS float* p = (const GAS float*)t.W + (size_t)(t.k0 + rr) * t.N + t.n0 + cc;
#pragma unroll
    for (int i = 0; i < 16; ++i) v[i] = __builtin_nontemporal_load((const GAS f32x4*)(p + (size_t)(4 * i) * t.N));
}
__device__ __forceinline__ void tr_to_lds(const f32x4 (&v)[16], LAS float* scr, int lane) {
    const int rr = lane >> 4, cc = (lane & 15) * 4;
#pragma unroll
    for (int i = 0; i < 16; ++i) { LAS float* s = scr + (4 * i + rr) * 65 + cc; s[0] = v[i].x; s[1] = v[i].y; s[2] = v[i].z; s[3] = v[i].w; }
}
__device__ __forceinline__ void tr_store(const TrItem& t, const LAS float* scr, int lane) {
    const int c = lane & 7;
#pragma unroll
    for (int j = 0; j < 8; ++j) { const int n = (lane >> 3) + 8 * j; const LAS float* s = scr + (8 * c) * 65 + n;
        v4u o; o.x = pk2(s[0 * 65], s[1 * 65]); o.y = pk2(s[2 * 65], s[3 * 65]); o.z = pk2(s[4 * 65], s[5 * 65]); o.w = pk2(s[6 * 65], s[7 * 65]);
        GAS v4u* dp = (GAS v4u*)(t.WT + (size_t)(t.drow0 + n) * t.ldT + t.dcol + 8 * c);
        if (t.nt) __builtin_nontemporal_store(o, dp); else *dp = o; }
}
__device__ __forceinline__ void tr_run(const Args& args, bf16* WinT, bf16* WoutT, bf16* WguT, bf16* WdT, int base, int first, int last, int stride, LAS float* scr, int lane) {
    if (first >= last) return;
    f32x4 v[16];
    TrItem cur = tr_decode(args, WinT, WoutT, WguT, WdT, base + first); tr_load(cur, v, lane);
    for (int it = first; it < last; it += stride) {
        tr_to_lds(v, scr, lane);
        LDS_WAIT(); asm volatile("" ::: "memory");
        TrItem nx = cur; const bool more = it + stride < last;
        if (more) { nx = tr_decode(args, WinT, WoutT, WguT, WdT, base + it + stride); tr_load(nx, v, lane); }
        tr_store(cur, scr, lane);
        LDS_WAIT(); asm volatile("" ::: "memory");
        cur = nx;
    }
}

__device__ __forceinline__ void ada_task(const Args& args, int col0, int kbase, int krows, float* out, size_t opitch, LAS float* scr, int lane) {
    for (int i = 0; i < krows / 64; ++i) { const int k = kbase + 64 * i + lane;
#pragma unroll
        for (int v = 0; v < NMODV; ++v) { const float cv = (v == 0) ? args.c_ctx[k] : args.c[(v - 1) * DM + k]; scr[(64 * i + lane) * 8 + v] = cv / (1.0f + expf(-cv)); } }
    LDS_WAIT(); asm volatile("" ::: "memory");
    f32x4 acc[NMODV];
#pragma unroll
    for (int v = 0; v < NMODV; ++v) acc[v] = (f32x4){0.f, 0.f, 0.f, 0.f};
    const GAS f32x4* wp = (const GAS f32x4*)(args.w_ada + (size_t)kbase * MODW + col0) + lane;
#pragma unroll 8
    for (int kk = 0; kk < krows; ++kk) { const f32x4 w = __builtin_nontemporal_load(wp + (size_t)kk * (MODW / 4)); const f32x4 s4 = *(const LAS f32x4*)(scr + kk * 8); const float s5 = scr[kk * 8 + 4];
        acc[0] += s4.x * w; acc[1] += s4.y * w; acc[2] += s4.z * w; acc[3] += s4.w * w; acc[4] += s5 * w; }
#pragma unroll
    for (int v = 0; v < NMODV; ++v) *(GAS f32x4*)(out + (size_t)v * opitch + 4 * lane) = acc[v];
    LDS_WAIT(); asm volatile("" ::: "memory");
}
__device__ __forceinline__ int gu_row(int n, bool up) { return (n >> 7) * 256 + (n & 127) + (up ? 128 : 0); }
__device__ __forceinline__ void amax_task(const float* W, int N, int col0, int ks, float* dst, int lane) {
    const GAS f32x4* wp = (const GAS f32x4*)(W + (size_t)(ks * 256) * N + col0) + lane;
    f32x4 mx = (f32x4){0.f, 0.f, 0.f, 0.f};
#pragma unroll 8
    for (int kk = 0; kk < 256; ++kk) { const f32x4 w = wp[(size_t)kk * (N / 4)]; mx.x = fmaxf(mx.x, fabsf(w.x)); mx.y = fmaxf(mx.y, fabsf(w.y)); mx.z = fmaxf(mx.z, fabsf(w.z)); mx.w = fmaxf(mx.w, fabsf(w.w)); }
    *(GAS f32x4*)dst = mx;
}
__device__ __forceinline__ void amax_task_rot(const float* W, int N, int col0, int ks, float* dst, int lane) {
    const GAS f32x4* wp = (const GAS f32x4*)(W + (size_t)(ks * 256) * N + col0) + lane;
    f32x4 mx = (f32x4){0.f, 0.f, 0.f, 0.f};
#pragma unroll 1
    for (int kk = 0; kk < 256; kk += 8) { f32x4 w[8];
#pragma unroll
        for (int e = 0; e < 8; ++e) w[e] = wp[(size_t)(kk + e) * (N / 4)];
#pragma unroll
        for (int cc = 0; cc < 4; ++cc) { float a[8];
#pragma unroll
            for (int e = 0; e < 8; ++e) a[e] = w[e][cc];
            pg8::wht8(a);
#pragma unroll
            for (int e = 0; e < 8; ++e) mx[cc] = fmaxf(mx[cc], fabsf(a[e])); } }
    *(GAS f32x4*)dst = mx;
}
template <int NPART, bool ROT>
__device__ __forceinline__ void quant_item(const float* W, int N, int kb, int n0, const float* amaxp, int apitch, signed char* Wq, size_t ldq, float* sW, LAS float* scr, int lane) {
    const int k0 = kb * 64;
    TrItem t; t.W = W; t.N = N; t.k0 = k0; t.n0 = n0; t.WT = nullptr; t.ldT = 0; t.drow0 = 0; t.dcol = 0; t.nt = false;
    f32x4 v[16]; tr_load(t, v, lane);
    LAS float* inv = scr + 64 * 65;
    if constexpr (NPART == 0) { const float sc = sW[lane]; inv[lane] = sc > 0.f ? 1.0f / sc : 0.f; }
    else { float am = 0.f;
#pragma unroll
        for (int p = 0; p < NPART; ++p) am = fmaxf(am, amaxp[(size_t)p * apitch + lane]);
        inv[lane] = am > 0.f ? 127.0f / am : 0.f;
        if (kb == 0) sW[lane] = am * (1.0f / 127.0f); }
    tr_to_lds(v, scr, lane);
    LDS_WAIT(); asm volatile("" ::: "memory");
    const int c = lane & 7;
#pragma unroll 2
    for (int j = 0; j < 8; ++j) { const int n = (lane >> 3) + 8 * j; const LAS float* sp = scr + (8 * c) * 65 + n; const float iv = inv[n];
        float a[8];
#pragma unroll
        for (int e = 0; e < 8; ++e) a[e] = sp[e * 65];
        if (ROT) pg8::wht8(a);
        v2u o; o.x = q8x4(a[0], a[1], a[2], a[3], iv); o.y = q8x4(a[4], a[5], a[6], a[7], iv);
        *(GAS v2u*)(Wq + (size_t)n * ldq + 8 * c) = o; }
    LDS_WAIT(); asm volatile("" ::: "memory");
}
__device__ __forceinline__ void quant_row_bf16(const bf16* src, signed char* dst, float* s_out, int lane) {
    const GAS v4u* sp = (const GAS v4u*)src + lane; v4u r[8]; float am = 0.f;
#pragma unroll
    for (int j = 0; j < 8; ++j) { r[j] = sp[64 * j];
        const unsigned w4[4] = {r[j].x, r[j].y, r[j].z, r[j].w};
#pragma unroll
        for (int e = 0; e < 4; ++e) am = fmaxf(am, fmaxf(fabsf(__uint_as_float(w4[e] << 16)), fabsf(__uint_as_float(w4[e] & 0xffff0000u)))); }
#pragma unroll
    for (int o = 1; o < 64; o <<= 1) am = fmaxf(am, __shfl_xor(am, o));
    const float iv = am > 0.f ? 127.0f / am : 0.f;
    if (lane == 0) *s_out = am * (1.0f / 127.0f);
    GAS v2u* dp = (GAS v2u*)dst + lane;
#pragma unroll
    for (int j = 0; j < 8; ++j) { const unsigned w4[4] = {r[j].x, r[j].y, r[j].z, r[j].w}; unsigned o2[2];
#pragma unroll
        for (int e = 0; e < 2; ++e) o2[e] = q8x4(__uint_as_float(w4[2 * e] << 16), __uint_as_float(w4[2 * e] & 0xffff0000u), __uint_as_float(w4[2 * e + 1] << 16), __uint_as_float(w4[2 * e + 1] & 0xffff0000u), iv);
        v2u o; o.x = o2[0]; o.y = o2[1]; dp[64 * j] = o; }
}
__device__ __forceinline__ void norm_quant_row(const float* xrow, const bf16* drow, signed char* orow, float* sa_out, const LAS float* A, const LAS float* B, int lane) {
    const GAS f32x4* xr = (const GAS f32x4*)xrow + lane; const GAS v2u* dr = (const GAS v2u*)drow + lane;
    f32x4 v[16]; float s = 0.f;
#pragma unroll
    for (int j = 0; j < 16; ++j) { v[j] = add_bf4(__builtin_nontemporal_load(xr + 64 * j), dr[64 * j]); s += (v[j].x * v[j].x + v[j].y * v[j].y) + (v[j].z * v[j].z + v[j].w * v[j].w); }
    const float rstd = 1.0f / sqrtf(wave_sum(s) * (1.f / DM) + EPS);
    float am = 0.f;
#pragma unroll
    for (int j = 0; j < 16; ++j) { const f32x4 a = *(const LAS f32x4*)(A + 256 * j + 4 * lane), b = *(const LAS f32x4*)(B + 256 * j + 4 * lane);
        v[j].x = v[j].x * rstd * a.x + b.x; v[j].y = v[j].y * rstd * a.y + b.y; v[j].z = v[j].z * rstd * a.z + b.z; v[j].w = v[j].w * rstd * a.w + b.w;
        am = fmaxf(fmaxf(am, fmaxf(fabsf(v[j].x), fabsf(v[j].y))), fmaxf(fabsf(v[j].z), fabsf(v[j].w)));
        if ((j & 3) == 3) asm volatile("" ::: "memory"); }
#pragma unroll
    for (int o = 1; o < 64; o <<= 1) am = fmaxf(am, __shfl_xor(am, o));
    const float iv = am > 0.f ? 127.0f / am : 0.f;
    if (lane == 0) *sa_out = am * (1.0f / 127.0f);
    GAS unsigned* o4 = (GAS unsigned*)orow + lane;
#pragma unroll
    for (int j = 0; j < 16; ++j) o4[64 * j] = q8x4(v[j].x, v[j].y, v[j].z, v[j].w, iv);
}

constexpr int N_AMAX = 2 * 43 * 16, N_AMAXO = 16 * 16, N_AMAXD = 16 * 43;
__device__ __forceinline__ void late_slice(const Args& args, bf16* WinT, bf16* WoutT, bf16* WguT, bf16* WdT, float* MODP2, float* AMAXP, float* AMAXO, float* AMAXD, int sidx, int G, int gw, LAS float* scr, int lane) {
    const int NGW = G * 8;
    if (sidx == 0) for (int a = gw; a < 64 * KSPLIT2; a += NGW) { const int cg = a % 64, sp = a / 64;
        ada_task(args, MODC1 + cg * 256, sp * (DM / KSPLIT2), DM / KSPLIT2, MODP2 + (size_t)(sp * NMODV) * (MODW - MODC1) + cg * 256, (size_t)(MODW - MODC1), scr, lane); }
    if (sidx == 1) { for (int a_ = gw + N_AMAXD; a_ < N_AMAXD + N_AMAX + N_AMAXO; a_ += NGW) { const int a = a_ - N_AMAXD;
            if (a < N_AMAX) { const int cg = a % 86, ks = a / 86; const bool up = cg >= 43; const int col0 = (cg % 43) * 256;
                amax_task(up ? args.w_up : args.w_gate, DFF, col0, ks, AMAXP + (size_t)ks * 22016 + gu_row(col0 + 4 * lane, up), lane); }
            else { const int b2 = a - N_AMAX, cg = b2 % 16, ks = b2 / 16; amax_task(args.w_out, DM, cg * 256, ks, AMAXO + (size_t)ks * DM + cg * 256 + 4 * lane, lane); } }
        for (int a = gw; a < N_AMAXD; a += NGW) { const int cg = a % 16, ks = a / 16; amax_task_rot(args.w_down, DM, cg * 256, ks, AMAXD + (size_t)ks * DM + cg * 256 + 4 * lane, lane); } }
}

template <bool DELTA>
__device__ __forceinline__ void norm_mod_row(const float* xrow, const bf16* drow, bf16* orow, const LAS float* A, const LAS float* B, int lane) {
    const GAS f32x4* xr = (const GAS f32x4*)xrow + lane; const GAS v2u* dr = (const GAS v2u*)drow + lane;
    f32x4 v[16]; float s = 0.f;
#pragma unroll
    for (int j = 0; j < 16; ++j) { v[j] = __builtin_nontemporal_load(xr + 64 * j); if (DELTA) v[j] = add_bf4(v[j], dr[64 * j]); s += (v[j].x * v[j].x + v[j].y * v[j].y) + (v[j].z * v[j].z + v[j].w * v[j].w); }
    const float rstd = 1.0f / sqrtf(wave_sum(s) * (1.f / DM) + EPS);
    GAS v2u* o8 = (GAS v2u*)orow + lane;
#pragma unroll
    for (int j = 0; j < 16; ++j) { const f32x4 a = *(const LAS f32x4*)(A + 256 * j + 4 * lane), b = *(const LAS f32x4*)(B + 256 * j + 4 * lane);
        v2u w; w.x = pk2(v[j].x * rstd * a.x + b.x, v[j].y * rstd * a.y + b.y); w.y = pk2(v[j].z * rstd * a.z + b.z, v[j].w * rstd * a.w + b.w); o8[64 * j] = w; }
}
__device__ __forceinline__ void norm_mod_row_dual(const float* xrow, bf16* orow, signed char* qrow, float* s_out, const LAS float* A, const LAS float* B, int lane) {
    const GAS f32x4* xr = (const GAS f32x4*)xrow + lane;
    f32x4 v[16]; float s = 0.f;
#pragma unroll
    for (int j = 0; j < 16; ++j) { v[j] = __builtin_nontemporal_load(xr + 64 * j); s += (v[j].x * v[j].x + v[j].y * v[j].y) + (v[j].z * v[j].z + v[j].w * v[j].w); }
    const float rstd = 1.0f / sqrtf(wave_sum(s) * (1.f / DM) + EPS);
    GAS v2u* o8 = (GAS v2u*)orow + lane; float am = 0.f;
#pragma unroll
    for (int j = 0; j < 16; ++j) { const f32x4 a = *(const LAS f32x4*)(A + 256 * j + 4 * lane), b = *(const LAS f32x4*)(B + 256 * j + 4 * lane);
        v[j].x = v[j].x * rstd * a.x + b.x; v[j].y = v[j].y * rstd * a.y + b.y; v[j].z = v[j].z * rstd * a.z + b.z; v[j].w = v[j].w * rstd * a.w + b.w;
        v2u w; w.x = pk2(v[j].x, v[j].y); w.y = pk2(v[j].z, v[j].w); o8[64 * j] = w;
        am = fmaxf(fmaxf(am, fmaxf(fabsf(v[j].x), fabsf(v[j].y))), fmaxf(fabsf(v[j].z), fabsf(v[j].w)));
        if ((j & 3) == 3) asm volatile("" ::: "memory"); }
#pragma unroll
    for (int o = 1; o < 64; o <<= 1) am = fmaxf(am, __shfl_xor(am, o));
    const float iv = am > 0.f ? 127.0f / am : 0.f;
    if (lane == 0) *s_out = am * (1.0f / 127.0f);
    GAS unsigned* o4 = (GAS unsigned*)qrow + lane;
#pragma unroll
    for (int j = 0; j < 16; ++j) o4[64 * j] = q8x4(v[j].x, v[j].y, v[j].z, v[j].w, iv);
}

__global__ void __launch_bounds__(512, 2) mega_fwd(Args args) {
    extern __shared__ __attribute__((aligned(16))) unsigned char lds[];
    LAS unsigned char* L = (LAS unsigned char*)lds;
    volatile LAS unsigned* MISC = (volatile LAS unsigned*)(L + MISC_OFF);
    const int tid = threadIdx.x, lane = tid & 63, wave = __builtin_amdgcn_readfirstlane(tid >> 6);
    const int G = gridDim.x, bx = blockIdx.x;
    unsigned char* ws = args.ws;
    gu32* ctl = (gu32*)(ws + WS_CTL);
    float* MODP = (float*)(ws + WS_MODP); float* MOD = (float*)(ws + WS_MOD); float* MODP2 = (float*)(ws + WS_MODP2); float* AMAXP = (float*)(ws + WS_AMAXP); float* AMAXO = (float*)(ws + WS_AMAXP + 1536 * 1024); float* SWq = (float*)(ws + WS_SW); float* SWo = (float*)(ws + WS_SW + 128 * 1024);
    float* SAq = (float*)(ws + WS_SA); float* SMq = (float*)(ws + WS_SA + 128 * 1024); signed char* Wo8 = (signed char*)(ws + WS_WOUT); signed char* MIX8 = (signed char*)(ws + WS_QKV);
    float* AMAXD = (float*)(ws + WS_AMAXD); float* AMAXU = (float*)(ws + WS_AMAXD + 768 * 1024); float* AMAXQ = (float*)(ws + WS_AMAXD + 896 * 1024); float* SWqq = (float*)(ws + WS_SW + 512 * 1024); float* SWu = (float*)(ws + WS_SW + 384 * 1024); float* SHa = (float*)(ws + WS_SA + 384 * 1024);
    signed char* Wu8 = (signed char*)(ws + WS_WOUT + 16 * MiB); signed char* Wqq8 = (signed char*)(ws + WS_WOUT + 24 * MiB); signed char* Wkv8 = (signed char*)(ws + WS_MIX); float* SWkv = (float*)(ws + WS_SW + 640 * 1024); signed char* H8a = (signed char*)(ws + WS_Y + 64 * MiB); float* SWd = (float*)(ws + WS_SW + 256 * 1024); float* SActq = (float*)(ws + WS_SA + 256 * 1024);
    signed char* Wd8 = (signed char*)(ws + WS_WD); signed char* ACT8 = (signed char*)(ws + WS_WGU); unsigned* ROWMAX = (unsigned*)(ws + WS_CTL + 512 * 1024);
    signed char* Wq8 = (signed char*)(ws + WS_WGU); signed char* H8 = (signed char*)(ws + WS_H);
    bf16 *WinT = (bf16*)(ws + WS_WIN), *WoutT = (bf16*)(ws + WS_WOUT), *WguT = (bf16*)(ws + WS_WGU), *WdT = (bf16*)(ws + WS_WD);
    bf16 *CK = (bf16*)(ws + WS_CK), *CV = (bf16*)(ws + WS_CV), *DT256 = (bf16*)(ws + WS_DT256), *D2 = (bf16*)(ws + WS_D2), *DT2048 = (bf16*)(ws + WS_DT2048);
    bf16 *H = (bf16*)(ws + WS_H), *MIX = (bf16*)(ws + WS_MIX), *QKV = (bf16*)(ws + WS_QKV), *UT = (bf16*)(ws + WS_UT), *Y = (bf16*)(ws + WS_Y), *ACT = (bf16*)(ws + WS_ACT), *DL1 = (bf16*)(ws + WS_DL1), *DL2 = (bf16*)(ws + WS_DL2);
    float* OUTY = args.out; float* OUTKV = args.out + (size_t)NTOK * DM;

    for (int u = tid; u < (LDS_BYTES - LDSCTL_OFF) / 4; u += 512) ((LAS unsigned*)(L + LDSCTL_OFF))[u] = 0u;
    __syncthreads();
    XcdBarrier bar; bar.bar = (unsigned*)(ctl + CW_BAR); bar.x = 0; bar.st = nullptr;
    if (MK_N_LAUNCHES == 1) bar = xcd_barrier_post((unsigned*)(ctl + CW_BAR), MISC + 8);
    const int lo = args.ph_lo, hi = args.ph_hi;
#define IN(k) (lo <= (k) && (k) < hi)
#define SEAM(k) do { if (IN(k) && IN((k) + 1)) xcd_barrier(bar); } while (0)

    if (IN(0)) {
        const int gw = bx * 8 + wave, NGW = G * 8;
        LAS float* scr = (LAS float*)(L + wave * 16640);
        constexpr int NADA = (MODC1 / 256) * KSPLIT;
        for (int a = gw; a < NADA; a += NGW) { const int cg = a % (MODC1 / 256), sp = a / (MODC1 / 256);
            ada_task(args, cg * 256, sp * 256, 256, MODP + (size_t)(sp * NMODV) * MODW + cg * 256, (size_t)MODW, scr, lane); }
        for (int a = NGW > NADA ? (gw >= NADA ? gw - NADA : gw + NGW - NADA) : gw; a < 2 * 8 * 16; a += NGW) { const bool isq = a >= 128; const int b2 = isq ? a - 128 : a, cg = b2 % 8, ks = b2 / 8;
            amax_task(args.w_in, 8192, (isq ? 0 : 6144) + cg * 256, ks, (isq ? AMAXQ : AMAXU) + (size_t)ks * 2048 + cg * 256 + 4 * lane, lane); }
        { const int nfree = NGW - NADA;
          if (nfree >= NADA) { if (gw >= NADA) tr_run(args, WinT, WoutT, WguT, WdT, 0, gw - NADA, TR_I_IN, nfree, scr, lane); }
          else tr_run(args, WinT, WoutT, WguT, WdT, 0, gw, TR_I_IN, NGW, scr, lane); }
        const int gt = bx * 512 + tid, NGT = G * 512;
        for (int i = gt; i < 2 * 262144; i += NGT) { const bool isv = i >= 262144; const int j = isv ? i - 262144 : i;
            const GAS f32x4* src = (const GAS f32x4*)((isv ? args.cache_v : args.cache_k) + (size_t)j * 8);
            const f32x4 a = src[0], b = src[1]; v4u o; o.x = pk2(a.x, a.y); o.y = pk2(a.z, a.w); o.z = pk2(b.x, b.y); o.w = pk2(b.z, b.w);
            *(GAS v4u*)((isv ? CV : CK) + (size_t)j * 8) = o; }
        constexpr int N8_A = 2048 * 2048 / 8, N8_B = 256 * 256 / 8, N8_C = 1024 * 1024 / 8;
        for (int i = gt; i < N8_A + N8_B + N8_C; i += NGT) {
            int T, row, col8; bf16* dst; float sgn = 1.f, nrm;
            if (i < N8_A) { T = 2048; row = i / 256; col8 = (i % 256) * 8; dst = DT2048 + (size_t)row * 2048 + col8; nrm = 0.022097086912079608f; }
            else if (i < N8_A + N8_B) { const int j = i - N8_A; T = 256; row = j / 32; col8 = (j % 32) * 8; dst = DT256 + (size_t)row * 256 + col8; nrm = 0.0625f; }
            else { const int j = i - N8_A - N8_B; T = 512; row = j / 128; col8 = (j % 128) * 8; dst = D2 + (size_t)row * 1024 + col8; nrm = 0.044194173824159216f; }
            int kf, t0; bool is_sin;
            if (i < N8_A + N8_B) { const int Th = T >> 1; is_sin = row > Th; kf = is_sin ? row - Th : row; t0 = col8; }
            else { is_sin = col8 >= 512; kf = row & 511; t0 = col8 & 511; sgn = is_sin ? (row < 512 ? -1.f : 1.f) : 1.f; }
            float vals[8];
#pragma unroll
            for (int e = 0; e < 8; ++e) { const int ph = (kf * (t0 + e)) & (T - 1); const float ang = (float)ph * (2.0f / (float)T);
                vals[e] = sgn * nrm * (is_sin ? sinpif(ang) : cospif(ang)); }
            v4u o; o.x = pk2(vals[0], vals[1]); o.y = pk2(vals[2], vals[3]); o.z = pk2(vals[4], vals[5]); o.w = pk2(vals[6], vals[7]);
            *(GAS v4u*)dst = o;
        }
    }
    SEAM(0);

    if (IN(1)) {
        LAS float* A1 = (LAS float*)L; LAS float* B1 = A1 + DM;
        for (int rc = bx; rc < NTOK / 64; rc += G) {
            const int bidx = rc < 128 ? 0 : 1 + ((rc - 128) >> 5);
            __syncthreads();
#pragma unroll 1
            for (int col = tid; col < DM; col += 512) { float sh = args.b_ada[col], sc = args.b_ada[DM + col];
#pragma unroll
                for (int k = 0; k < KSPLIT; ++k) { const float* mp = MODP + ((size_t)(k * NMODV + bidx)) * MODW; sh += mp[col]; sc += mp[DM + col]; }
                A1[col] = args.norm1_g[col] * (1.0f + sc); B1[col] = sh; }
            __syncthreads();
#pragma unroll 1
            for (int i = 0; i < 8; ++i) { const int row = rc * 64 + wave * 8 + i;
                const float* xr = row < NPROMPT ? args.x_prompt + (size_t)row * DM : args.x_sample + (size_t)(row - NPROMPT) * DM;
                norm_mod_row_dual(xr, H + (size_t)row * DM, H8a + (size_t)row * DM, SHa + row, A1, B1, lane); }
        }
        __syncthreads();
        { LAS float* scr = (LAS float*)(L + wave * 16896);
          for (int it = bx * 8 + wave; it < 2 * 64 * 32; it += G * 8) { const bool isq = it >= 64 * 32; const int r = isq ? it - 64 * 32 : it, kb = r / 32, nb = r % 32;
              quant_item<16, false>(args.w_in, 8192, kb, (isq ? 0 : 6144) + nb * 64, (isq ? AMAXQ : AMAXU) + nb * 64, 2048, (isq ? Wqq8 : Wu8) + (size_t)(nb * 64) * DM + kb * 64, (size_t)DM, (isq ? SWqq : SWu) + nb * 64, scr, lane); } }
        for (int n = bx * 8 + wave; n < 2 * DATT; n += G * 8) quant_row_bf16(WinT + (size_t)(DATT + n) * DM, Wkv8 + (size_t)n * DM, SWkv + n, lane);
    }
    SEAM(1);

    if (IN(2)) {
        const int gw2 = bx * 8 + wave; LAS float* scr2 = (LAS float*)(L + wave * 16640);
        { const pg8::Gemm g = pg8::gemm_rowmajor(DM, DM, DM); pg8::QkvSched S; S.init(G, bx, H, WinT, 0, 2);
          pg8::EpiQKV E{QKV, OUTKV};
          pg8::gemm_phase<pg8::EpiQKV, pg8::QkvSched, true>(L, g, S, E); }
        __syncthreads(); late_slice(args, WinT, WoutT, WguT, WdT, MODP2, AMAXP, AMAXO, AMAXD, 0, G, gw2, scr2, lane); __syncthreads();
        if (G == 256) { const pg8::Gemm g = pg8::gemm_rowmajor(DM / 2, DM / 2, DM / 2); pg8::TileSched S;
          S.init(32, 16, 1, G, bx, H8a + (size_t)32 * 256 * DM, Wkv8, (size_t)256 * DM, (size_t)256 * DM, 0, 0); S.pm0 = 32; S.pn0 = 8;
          pg8::EpiKV8 E{QKV, SHa, SWkv};
          pg8::gemm_phase<pg8::EpiKV8, pg8::TileSched, true, true>(L, g, S, E); }
        else { const pg8::Gemm g = pg8::gemm_rowmajor(DM, DM, DM); pg8::QkvSched S; S.init(G, bx, H, WinT, 2, 1 << 20);
          pg8::EpiQKV E{QKV, OUTKV};
          pg8::gemm_phase<pg8::EpiQKV, pg8::QkvSched, true>(L, g, S, E); }
        __syncthreads(); late_slice(args, WinT, WoutT, WguT, WdT, MODP2, AMAXP, AMAXO, AMAXD, 1, G, gw2, scr2, lane); __syncthreads();
        { const pg8::Gemm g = pg8::gemm_rowmajor(DM / 2, DM / 2, DM / 2); pg8::TileSched S; S.init(64, 8, 1, G, bx, H8a, Wqq8, (size_t)256 * DM, (size_t)256 * DM, 0, 0);
          pg8::EpiQ8 E{QKV, SHa, SWqq};
          pg8::gemm_phase<pg8::EpiQ8, pg8::TileSched, true, true>(L, g, S, E); }
        { const pg8::Gemm g = pg8::gemm_rowmajor(DM / 2, DM / 2, DM / 2); pg8::TileSched S; S.init(8, 64, 1, G, bx, Wu8, H8a, (size_t)256 * DM, (size_t)256 * DM, 0, 0);
          pg8::EpiUT8 E{UT, SWu, SHa};
          pg8::gemm_phase<pg8::EpiUT8, pg8::TileSched, true, true>(L, g, S, E); }
    }
    SEAM(2);

    if (IN(3)) {
        const bf16* Qb = QKV; const bf16* Kb = QKV + (size_t)NTOK * DATT; const bf16* Vb = QKV + (size_t)2 * NTOK * DATT;
        for (int u = bx; u < 512; u += G) {
            const int b = u >> 4, h = u & 15; const size_t ro = (size_t)(b * 256) * DATT + h * HD;
            att::AttnUnit U{Qb + ro, Kb + ro, Vb + ro, Kb + ro, Vb + ro, MIX + (size_t)(b * 256) * DM + h * HD, nullptr, 4, 0, 0, 0};
            att::attn_unit<false>(U, (char*)lds);
        }
        for (int u = bx; u < 512; u += G) {
            const int rb = u & 7, h = (u >> 3) & 15, b = u >> 7, r0 = rb * 4;
            const int kr0 = rb == 0 ? 0 : (rb == 7 ? 24 : r0 - 4), n0 = (rb == 0 || rb == 7) ? 8 : 12;
            const size_t tok0 = NPROMPT + (size_t)b * 2048; const size_t co = (size_t)(b * 256) * DATT + h * HD;
            att::AttnUnit U{Qb + (tok0 + r0 * 64) * DATT + h * HD, Kb + (tok0 + kr0 * 64) * DATT + h * HD, Vb + (tok0 + kr0 * 64) * DATT + h * HD,
                            CK + co, CV + co, MIX + (tok0 + r0 * 64) * DM + h * HD, args.rpb + h * 15 * 31, n0, 4, r0, kr0};
            att::attn_unit<true>(U, (char*)lds);
        }
        __syncthreads();
        { const pg8::Gemm g = pg8::gemm_rowmajor(256, NTOK, 256); pg8::TileSched S; S.init(1, 8, 32, G, bx, DT256, UT, (size_t)256 * 256 * 2, (size_t)256 * NTOK * 2, 0, (size_t)256 * 2);
          pg8::EpiY2 E{Y, 128, 0};
          pg8::gemm_phase<pg8::EpiY2, pg8::TileSched, true>(L, g, S, E); }
        { const pg8::Gemm g = pg8::gemm_rowmajor(2048, NTOK, 2048); pg8::TileSched S; S.init(8, 8, 4, G, bx, DT2048, UT + NPROMPT, (size_t)256 * 2048 * 2, (size_t)256 * NTOK * 2, 0, (size_t)2048 * 2);
          pg8::EpiY2 E{Y, 1024, 4096};
          pg8::gemm_phase<pg8::EpiY2, pg8::TileSched, true>(L, g, S, E); }
    }
    SEAM(3);

    if (IN(4)) {
        for (int idx = bx * 512 + tid; idx < NMODV * MODW; idx += G * 512) { const int v = idx / MODW, j = idx % MODW; float sm = args.b_ada[j];
            if (j < MODC1) {
#pragma unroll
                for (int k = 0; k < KSPLIT; ++k) sm += MODP[((size_t)(k * NMODV + v)) * MODW + j]; }
            else {
#pragma unroll 8
                for (int k = 0; k < KSPLIT2; ++k) sm += MODP2[((size_t)(k * NMODV + v)) * (MODW - MODC1) + (j - MODC1)]; }
            MOD[idx] = sm; }
        { LAS float* scr = (LAS float*)(L + wave * 16896);
          for (int it = bx * 8 + wave; it < TR_I_OUT; it += G * 8) { const int kb = it / 64, nb = it % 64; quant_item<16, false>(args.w_out, DM, kb, nb * 64, AMAXO + nb * 64, DM, Wo8 + (size_t)(nb * 64) * DM + kb * 64, (size_t)DM, SWo + nb * 64, scr, lane); } }
        __syncthreads();
        for (int t = bx * 8 + wave; t < 36 * 4 * 2 * 8; t += G * 8) {
            const int chunk = t & 7, which = (t >> 3) & 1, g = (t >> 4) & 3, bb = t >> 6;
            int R, T, tok0; if (bb < 32) { R = bb * 128; T = 256; tok0 = bb * 256; } else { R = 4096 + (bb - 32) * 1024; T = 2048; tok0 = NPROMPT + (bb - 32) * 2048; }
            const GAS v4u* yp = (const GAS v4u*)(Y + (size_t)R * DM + g * 1024 + which * 512);
            const int kc = chunk * 64 + lane; const GAS v4u* dp = (const GAS v4u*)(D2 + (size_t)kc * 1024);
            float a0 = 0.f, a1 = 0.f;
#pragma unroll 16
            for (int c8 = 0; c8 < 64; ++c8) { const v4u y = yp[c8], d = dp[c8];
                a0 += __uint_as_float(y.x << 16) * __uint_as_float(d.x << 16); a1 += __uint_as_float(y.x & 0xffff0000u) * __uint_as_float(d.x & 0xffff0000u);
                a0 += __uint_as_float(y.y << 16) * __uint_as_float(d.y << 16); a1 += __uint_as_float(y.y & 0xffff0000u) * __uint_as_float(d.y & 0xffff0000u);
                a0 += __uint_as_float(y.z << 16) * __uint_as_float(d.z << 16); a1 += __uint_as_float(y.z & 0xffff0000u) * __uint_as_float(d.z & 0xffff0000u);
                a0 += __uint_as_float(y.w << 16) * __uint_as_float(d.w << 16); a1 += __uint_as_float(y.w & 0xffff0000u) * __uint_as_float(d.w & 0xffff0000u); }
            MIX[(size_t)(tok0 + (which ? (T >> 1) : 0)) * DM + DATT + g * 512 + kc] = (bf16)f2bf(a0 + a1);
        }
        const pg8::Gemm g = pg8::gemm_rowmajor(DM, 1024, 1024); pg8::TileSched S; S.init(32, 4, 4, G, bx, Y, D2, (size_t)256 * DM * 2, (size_t)256 * 1024 * 2, (size_t)1024 * 2, 0);
        pg8::EpiF2x E{MIX};
        pg8::gemm_phase<pg8::EpiF2x, pg8::TileSched, true>(L, g, S, E);
    }
    SEAM(4);

    if (IN(5)) {
        for (int row = bx * 8 + wave; row < NTOK; row += G * 8) quant_row_bf16(MIX + (size_t)row * DM, MIX8 + (size_t)row * DM, SMq + row, lane);
        for (int n = bx * 512 + tid; n < DM; n += G * 512) { float am = 0.f;
#pragma unroll
            for (int p = 0; p < 43; ++p) am = fmaxf(am, AMAXD[(size_t)p * DM + n]);
            SWd[n] = am * (1.0f / 127.0f); }
    }
    SEAM(5);

    if (IN(6)) {
        const pg8::Gemm g = pg8::gemm_rowmajor(DM / 2, DM / 2, DM / 2); pg8::TileSched S; S.init(64, 16, 1, G, bx, MIX8, Wo8, (size_t)256 * DM, (size_t)256 * DM, 0, 0);
        pg8::EpiDelta8 E{DL1, MOD + 2 * DM, SMq, SWo};
        pg8::gemm_phase<pg8::EpiDelta8, pg8::TileSched, true, true>(L, g, S, E);
    }
    SEAM(6);

    if (IN(7)) {
        LAS float* A1 = (LAS float*)L; LAS float* B1 = A1 + DM;
        for (int rc = bx; rc < NTOK / 64; rc += G) {
            const int bidx = rc < 128 ? 0 : 1 + ((rc - 128) >> 5);
            __syncthreads();
#pragma unroll 2
            for (int col = tid; col < DM; col += 512) { const float* mp = MOD + (size_t)bidx * MODW; A1[col] = args.norm2_g[col] * (1.0f + mp[4 * DM + col]); B1[col] = mp[3 * DM + col]; }
            __syncthreads();
#pragma unroll 1
            for (int i = 0; i < 8; ++i) { const int row = rc * 64 + wave * 8 + i;
                const float* xr = row < NPROMPT ? args.x_prompt + (size_t)row * DM : args.x_sample + (size_t)(row - NPROMPT) * DM;
                norm_quant_row(xr, DL1 + (size_t)row * DM, H8 + (size_t)row * DM, SAq + row, A1, B1, lane); }
        }
        __syncthreads();
        { LAS float* scr = (LAS float*)(L + wave * 16896);
          for (int it = bx * 8 + wave; it < 2 * TR_I_G; it += G * 8) { const bool up = it >= TR_I_G; const int r = up ? it - TR_I_G : it; const int kb = r / 172, n0 = (r % 172) * 64, r0 = gu_row(n0, up); quant_item<16, false>(up ? args.w_up : args.w_gate, DFF, kb, n0, AMAXP + r0, 22016, Wq8 + (size_t)r0 * DM + kb * 64, (size_t)DM, SWq + r0, scr, lane); } }
        { LAS float* scr = (LAS float*)(L + wave * 16896);
          for (int it = bx * 8 + wave; it < TR_I_D; it += G * 8) { const int kb = it / 64, nb = it % 64;
              quant_item<0, true>(args.w_down, DM, kb, nb * 64, nullptr, 0, Wd8 + ((size_t)((nb >> 2) * (DFF / 128) + (kb >> 1)) * 256 + (nb & 3) * 64) * 128 + (kb & 1) * 64, (size_t)128, SWd + nb * 64, scr, lane); } }
    }
    SEAM(7);

    if (IN(8)) {
        const pg8::Gemm g = pg8::gemm_rowmajor(DM / 2, DM / 2, DM / 2); pg8::TileSched S; S.init(64, 86, 1, G, bx, H8, Wq8, (size_t)256 * DM, (size_t)256 * DM, 0, 0);
        pg8::EpiSwiglu8 E{ACT, SAq, SWq, ROWMAX};
        pg8::gemm_phase<pg8::EpiSwiglu8, pg8::TileSched, true, true>(L, g, S, E);
    }
    SEAM(8);

    if (IN(9)) {
        for (int it = bx * 8 + wave; it < 64 * (DFF / 128); it += G * 8) { const int pm = it / (DFF / 128), kt8 = it % (DFF / 128);
            const bf16* src = ACT + (size_t)(pm * (DFF / 64) + 2 * kt8) * 256 * 64; signed char* dst = ACT8 + (size_t)(pm * (DFF / 128) + kt8) * 256 * 128; const int c = lane & 7;
            const bf16* srcl = src + (size_t)(c >> 2) * 256 * 64 + (c & 3) * 16;
            if (kt8 == 0 && c == 0) { for (int j = 0; j < 32; ++j) { const int row = (lane >> 3) + 8 * j; SActq[pm * 256 + row] = __uint_as_float(ROWMAX[pm * 256 + row]) * (1.0f / 127.0f); } }
#pragma unroll 1
            for (int j0 = 0; j0 < 32; j0 += 8) {
                v4u r0[8], r1[8]; float rm[8];
#pragma unroll
                for (int jj = 0; jj < 8; ++jj) { const int row = (lane >> 3) + 8 * (j0 + jj); rm[jj] = __uint_as_float(ROWMAX[pm * 256 + row]);
                    r0[jj] = __builtin_nontemporal_load((const GAS v4u*)(srcl + row * 64)); r1[jj] = __builtin_nontemporal_load((const GAS v4u*)(srcl + row * 64 + 8)); }
#pragma unroll
                for (int jj = 0; jj < 8; ++jj) { const int row = (lane >> 3) + 8 * (j0 + jj); const float iv = rm[jj] > 0.f ? 127.0f * __builtin_amdgcn_rcpf(rm[jj]) : 0.f;
                    const unsigned w8[8] = {r0[jj].x, r0[jj].y, r0[jj].z, r0[jj].w, r1[jj].x, r1[jj].y, r1[jj].z, r1[jj].w}; unsigned o4[4];
#pragma unroll
                    for (int e = 0; e < 4; ++e) o4[e] = q8x4(__uint_as_float(w8[2 * e] << 16), __uint_as_float(w8[2 * e] & 0xffff0000u), __uint_as_float(w8[2 * e + 1] << 16), __uint_as_float(w8[2 * e + 1] & 0xffff0000u), iv);
                    v4u o; o.x = o4[0]; o.y = o4[1]; o.z = o4[2]; o.w = o4[3]; *(GAS v4u*)(dst + (size_t)row * 128 + c * 16) = o; }
            }
        }
    }
    SEAM(9);

    if (IN(10)) {
        const pg8::Gemm g{64, 64, DFF / 2, (size_t)32768, (size_t)32768, (size_t)16384, (size_t)16384};
        pg8::TileSched S; S.init(64, 16, 1, G, bx, ACT8, Wd8, (size_t)256 * DFF, (size_t)256 * DFF, 0, 0);
        pg8::EpiDelta8 E{DL2, MOD + 5 * DM, SActq, SWd};
        pg8::gemm_phase<pg8::EpiDelta8, pg8::TileSched, true, true>(L, g, S, E);
    }
    SEAM(10);

    if (IN(11)) {
        for (int row = bx * 8 + wave; row < NTOK; row += G * 8) {
            const float* xrow = row < NPROMPT ? args.x_prompt + (size_t)row * DM : args.x_sample + (size_t)(row - NPROMPT) * DM;
            const GAS f32x4* xr = (const GAS f32x4*)xrow + lane; const GAS f32x4* gr = (const GAS f32x4*)args.final_g + lane;
            const GAS v2u* d1 = (const GAS v2u*)(DL1 + (size_t)row * DM) + lane; const GAS v2u* d2 = (const GAS v2u*)(DL2 + (size_t)row * DM) + lane;
            GAS f32x4* yr = (GAS f32x4*)(OUTY + (size_t)row * DM) + lane;
            f32x4 v[16]; float s = 0.f;
#pragma unroll
            for (int j = 0; j < 16; ++j) { v[j] = add_bf4(add_bf4(__builtin_nontemporal_load(xr + 64 * j), __builtin_nontemporal_load(d1 + 64 * j)), __builtin_nontemporal_load(d2 + 64 * j)); s += (v[j].x * v[j].x + v[j].y * v[j].y) + (v[j].z * v[j].z + v[j].w * v[j].w); }
            const float rstd = 1.0f / sqrtf(wave_sum(s) * (1.f / DM) + EPS);
#pragma unroll
            for (int j = 0; j < 16; ++j) __builtin_nontemporal_store(v[j] * rstd * gr[64 * j], yr + 64 * j);
        }
    }
#undef IN
#undef SEAM
}

extern "C" void kernel_launch(void* const* d_in, const int* in_sizes, int n_in, void* d_out, int out_size, void* d_ws, size_t ws_size, hipStream_t stream) {
    static int grid = 0;
    if (grid == 0) {
        if (n_in != 17 || ws_size < WS_END) { fprintf(stderr, "kernel_launch: need 17 inputs and >= %zu bytes of workspace; got %d, %zu\n", (size_t)WS_END, n_in, ws_size); grid = -1; return; }
        int dev = 0, cus = 0, per_cu = 0;
        if (hipGetDevice(&dev) != hipSuccess || hipDeviceGetAttribute(&cus, hipDeviceAttributeMultiprocessorCount, dev) != hipSuccess) { grid = -1; return; }
        if (hipFuncSetAttribute((const void*)mega_fwd, hipFuncAttributeMaxDynamicSharedMemorySize, LDS_BYTES) != hipSuccess) { fprintf(stderr, "kernel_launch: hipFuncSetAttribute failed\n"); grid = -1; return; }
        if (hipOccupancyMaxActiveBlocksPerMultiprocessor(&per_cu, (const void*)mega_fwd, 512, LDS_BYTES) != hipSuccess || per_cu < 1)
            fprintf(stderr, "kernel_launch: note: occupancy query reports %d workgroups per CU\n", per_cu);
        (void)hipGetLastError();
        grid = cus;
    }
    if (grid < 0) return;
    if (hipMemsetAsync((char*)d_ws + WS_CTL, 0, CTL_ZERO_BYTES, stream) != hipSuccess) return;
    Args a{};
    a.x_prompt = (const float*)d_in[0]; a.x_sample = (const float*)d_in[1]; a.cache_k = (const float*)d_in[2]; a.cache_v = (const float*)d_in[3];
    a.c = (const float*)d_in[4]; a.c_ctx = (const float*)d_in[5]; a.w_ada = (const float*)d_in[6]; a.b_ada = (const float*)d_in[7]; a.norm1_g = (const float*)d_in[8];
    a.w_in = (const float*)d_in[9]; a.rpb = (const float*)d_in[10]; a.w_out = (const float*)d_in[11]; a.norm2_g = (const float*)d_in[12];
    a.w_gate = (const float*)d_in[13]; a.w_up = (const float*)d_in[14]; a.w_down = (const float*)d_in[15]; a.final_g = (const float*)d_in[16];
    a.out = (float*)d_out; a.ws = (unsigned char*)d_ws;
    constexpr int NPH = 12;
    if (MK_N_LAUNCHES == 1) {
        a.ph_lo = 0; a.ph_hi = NPH;
        hipLaunchKernelGGL(mega_fwd, dim3(grid), dim3(512), LDS_BYTES, stream, a);
    } else {
        for (int p = 0; p < NPH; ++p) { a.ph_lo = p; a.ph_hi = p + 1; hipLaunchKernelGGL(mega_fwd, dim3(grid), dim3(512), LDS_BYTES, stream, a);
        }
    }
    const hipError_t le = hipPeekAtLastError();
    if (le != hipSuccess) fprintf(stderr, "kernel_launch: launch failed: %s\n", hipGetErrorName(le));
}
```

```cpp
#include <hip/hip_runtime.h>
#include <hip/hip_bf16.h>
#include <cstdio>
#include <cstdint>

#ifndef MK_N_LAUNCHES
#define MK_N_LAUNCHES 1
#endif

constexpr int DM = 4096, NTOK = 16384, NPROMPT = 8192, DATT = 2048, DFF = 11008, NH = 16, HD = 128;
constexpr int NMODV = 5, MODW = 6 * DM;
constexpr int KSPLIT = 16, KSPLIT2 = 32, MODC1 = 8192;
constexpr float EPS = 1e-6f;

constexpr size_t MiB = 1u << 20;
constexpr size_t WS_CTL = 0, CTL_ZERO_BYTES = 1 * MiB;
constexpr size_t WS_MODP = 1 * MiB;
constexpr size_t WS_MOD = 9 * MiB;
constexpr size_t WS_WIN = 10 * MiB;
constexpr size_t WS_WOUT = WS_WIN + 64 * MiB;
constexpr size_t WS_WGU = WS_WOUT + 32 * MiB;
constexpr size_t WS_WD = WS_WGU + 172 * MiB;
constexpr size_t WS_CK = WS_WD + 86 * MiB;
constexpr size_t WS_CV = WS_CK + 4 * MiB;
constexpr size_t WS_DT256 = WS_CV + 4 * MiB;
constexpr size_t WS_D2 = WS_DT256 + 1 * MiB;
constexpr size_t WS_DT2048 = WS_D2 + 2 * MiB;
constexpr size_t WS_H = WS_DT2048 + 16 * MiB;
constexpr size_t WS_MIX = WS_H + 128 * MiB;
constexpr size_t WS_QKV = WS_MIX + 128 * MiB;
constexpr size_t WS_UT = WS_QKV + 192 * MiB;
constexpr size_t WS_Y = WS_UT + 64 * MiB;
constexpr size_t WS_ACT = WS_QKV;
constexpr size_t WS_DL1 = WS_Y + 128 * MiB;
constexpr size_t WS_DL2 = WS_H;
constexpr size_t WS_MODP2 = WS_DL1 + 128 * MiB;
constexpr size_t WS_AMAXP = WS_MODP2 + 11 * MiB;
constexpr size_t WS_SW = WS_AMAXP + 2 * MiB;
constexpr size_t WS_SA = WS_SW + 1 * MiB;
constexpr size_t WS_AMAXD = WS_SA + 1 * MiB;
constexpr size_t WS_END = WS_AMAXD + 1 * MiB;
static_assert(WS_ACT + (size_t)NTOK * DFF * 2 <= WS_END, "ACT overlay");

constexpr int CW_BAR = 4096;

constexpr int RING_BYTES = 131072;
constexpr int LDSCTL_OFF = 146944, MISC_OFF = LDSCTL_OFF + 320;
constexpr int LDS_BYTES = 147456;

#define GAS __attribute__((address_space(1)))
#define LAS __attribute__((address_space(3)))
typedef unsigned short bf16;
typedef unsigned v4u __attribute__((ext_vector_type(4)));
typedef unsigned v2u __attribute__((ext_vector_type(2)));
typedef GAS unsigned gu32;
#define RLX_AGENT __ATOMIC_RELAXED, __HIP_MEMORY_SCOPE_AGENT
#define LDS_WAIT() asm volatile("s_waitcnt lgkmcnt(0)" ::: "memory")
#define VM_WAIT() asm volatile("s_waitcnt vmcnt(0)" ::: "memory")

namespace pg8 {
#define PG8_LAS __attribute__((address_space(3)))
typedef unsigned short bf16_t;
typedef short bf16x8 __attribute__((ext_vector_type(8)));
typedef float f32x4 __attribute__((ext_vector_type(4)));
typedef float f32x2 __attribute__((ext_vector_type(2)));
typedef unsigned u32x4 __attribute__((ext_vector_type(4)));
constexpr int BM = 256, BK = 64, HALF = 128, HTB = HALF * BK * 2, STAGE_BYTES = 8 * HTB, NXCD = 8, WGM = 8;

__host__ __device__ __forceinline__ int lds_byte(int r, int c) { const int st = (r >> 4) * 2 + (c >> 5), rr = r & 15, cc = c & 31, ob = rr * 64 + cc * 2; return st * 1024 + (ob ^ (((ob >> 9) & 1) << 5)); }
__host__ __device__ __forceinline__ void stage_rc(int b, int& R, int& C) { const int st = b / 1024, sb = b % 1024, swz = sb ^ (((sb >> 9) & 1) << 5); R = (st >> 1) * 16 + swz / 64; C = (st & 1) * 32 + (swz % 64) / 2; }
__host__ __device__ __forceinline__ int perm32(int rho) { const int n = rho >> 4, i = rho & 15; return 8 * (i >> 2) + 4 * n + (i & 3); }

struct Unit { const char* a; const char* b; int pm, pn, z; };
struct Gemm { int lda, ldb, K; size_t kstepA, kstepB, hstepA, hstepB; };
__device__ __forceinline__ Gemm gemm_rowmajor(int lda, int ldb, int K) { return Gemm{lda, ldb, K, (size_t)(BK * 2), (size_t)(BK * 2), (size_t)HALF * lda * 2, (size_t)HALF * ldb * 2}; }

struct TileSched {
    int nM, nN, per, nwg, G, c, wgm = WGM, pm0 = 0, pn0 = 0; const char* A; const char* B; size_t a_tile, b_tile, a_z, b_z;
    __device__ void init(int nM_, int nN_, int nZ_, int G_, int c_, const void* A_, const void* B_, size_t a_tile_, size_t b_tile_, size_t a_z_, size_t b_z_) {
        nM = nM_; nN = nN_; per = nM_ * nN_; nwg = per * nZ_; G = G_; c = c_; A = (const char*)A_; B = (const char*)B_; a_tile = a_tile_; b_tile = b_tile_; a_z = a_z_; b_z = b_z_; }
    __device__ bool next(int i, Unit& u) const {
        const long L = (long)i * G + c; if (L >= nwg) return false;
        int wgid = (int)L; { const int q = nwg / NXCD, r = nwg % NXCD, xcd = wgid % NXCD, off = wgid / NXCD; wgid = (xcd < r ? xcd * (q + 1) : r * (q + 1) + (xcd - r) * q) + off; }
        const int z = wgid / per, w = wgid % per;
        const int nig = wgm * nN, gid = w / nig, fm = gid * wgm, gsz = (nM - fm) < wgm ? (nM - fm) : wgm;
        u.pm = fm + ((w % nig) % gsz); u.pn = (w % nig) / gsz; u.z = z;
        u.a = A + (size_t)z * a_z + (size_t)u.pm * a_tile; u.b = B + (size_t)z * b_z + (size_t)u.pn * b_tile; u.pm += pm0; u.pn += pn0; return true;
    }
};
struct QkvSched {
    TileSched kvp, smp, plain; bool split; int i0, i1;
    __device__ void init(int G, int c, const bf16_t* Hm, const bf16_t* W, int i0_, int i1_) {
        const size_t tb = (size_t)256 * DM * 2; split = (G == 256); i0 = i0_; i1 = i1_;
        plain.init(64, 16, 1, G, c, Hm, W + (size_t)8 * 256 * DM, tb, tb, 0, 0); plain.pn0 = 8;
        kvp.init(32, 16, 1, G, c, Hm, W + (size_t)8 * 256 * DM, tb, tb, 0, 0); kvp.pn0 = 8;
        smp.init(32, 16, 1, G, c, Hm + (size_t)32 * 256 * DM, W + (size_t)8 * 256 * DM, tb, tb, 0, 0); smp.pm0 = 32; smp.pn0 = 8;
    }
    __device__ bool next(int i_, Unit& u) const {
        const int i = i_ + i0; if (i >= i1) return false;
        if (!split) return plain.next(i, u);
        if (i < 2) return kvp.next(i, u);
        return smp.next(i - 2, u);
    }
};

__device__ __forceinline__ unsigned cvt_pk_bf16(float lo, float hi) { unsigned r; asm volatile("v_cvt_pk_bf16_f32 %0, %1, %2" : "=v"(r) : "v"(lo), "v"(hi)); return r; }

__device__ __forceinline__ void store_tile_bf16(const f32x4 (&acc)[2][2][4][2], bf16_t* base, size_t ldc, int wr, int wc, int fr, int fq) {
    bf16_t* p0 = base + (size_t)(wr * 64 + fr) * ldc + wc * 32 + 8 * fq;
#pragma unroll
    for (int ai = 0; ai < 2; ++ai)
#pragma unroll
        for (int m = 0; m < 4; ++m) { bf16_t* rowp = p0 + (size_t)(ai * HALF + m * 16) * ldc;
#pragma unroll
            for (int bj = 0; bj < 2; ++bj) { const f32x4 v0 = acc[ai][bj][m][0], v1 = acc[ai][bj][m][1];
                u32x4 w; w.x = cvt_pk_bf16(v0[0], v0[1]); w.y = cvt_pk_bf16(v0[2], v0[3]); w.z = cvt_pk_bf16(v1[0], v1[1]); w.w = cvt_pk_bf16(v1[2], v1[3]);
                *(u32x4*)(rowp + bj * HALF) = w; } }
}

struct EpiQKV {
    static constexpr bool PERM = true;
    bf16_t* QKV; float* outkv;
    __device__ __forceinline__ void operator()(const f32x4 (&acc)[2][2][4][2], const Unit& u, int wr, int wc, int fr, int fq) const {
        const int t = u.pn >> 3, colt = (u.pn & 7) * 256;
        bf16_t* base = QKV + (size_t)t * NTOK * DATT + (size_t)(u.pm * 256) * DATT + colt;
        store_tile_bf16(acc, base, DATT, wr, wc, fr, fq);
        if (u.pm < 32 && t >= 1) {
            float* p0 = outkv + (size_t)(t - 1) * NPROMPT * DATT + (size_t)(u.pm * 256 + wr * 64 + fr) * DATT + colt + wc * 32 + 8 * fq;
#pragma unroll
            for (int ai = 0; ai < 2; ++ai)
#pragma unroll
                for (int m = 0; m < 4; ++m) { float* rowp = p0 + (size_t)(ai * HALF + m * 16) * DATT;
#pragma unroll
                    for (int bj = 0; bj < 2; ++bj) { __builtin_nontemporal_store(acc[ai][bj][m][0], (f32x4*)(rowp + bj * HALF)); __builtin_nontemporal_store(acc[ai][bj][m][1], (f32x4*)(rowp + bj * HALF + 4)); } }
        }
    }
};
struct EpiUT {
    static constexpr bool PERM = true; bf16_t* UT;
    __device__ __forceinline__ void operator()(const f32x4 (&acc)[2][2][4][2], const Unit& u, int wr, int wc, int fr, int fq) const {
        store_tile_bf16(acc, UT + (size_t)(u.pm * 256) * NTOK + u.pn * 256, NTOK, wr, wc, fr, fq); }
};
__device__ __forceinline__ void store_half_bf16(const f32x4 (&a)[2][4][2], bf16_t* base, long rstride, int skip_r, int wr, int wc, int fr, int fq) {
#pragma unroll
    for (int m = 0; m < 4; ++m) { const int r = wr * 64 + m * 16 + fr; bf16_t* rowp = base + (long)r * rstride + wc * 32 + 8 * fq;
        if (r != skip_r) {
#pragma unroll
            for (int bj = 0; bj < 2; ++bj) { const f32x4 v0 = a[bj][m][0], v1 = a[bj][m][1];
                u32x4 w; w.x = cvt_pk_bf16(v0[0], v0[1]); w.y = cvt_pk_bf16(v0[2], v0[3]); w.z = cvt_pk_bf16(v1[0], v1[1]); w.w = cvt_pk_bf16(v1[2], v1[3]);
                *(u32x4*)(rowp + bj * HALF) = w; } } }
}
struct EpiY2 {
    static constexpr bool PERM = true; bf16_t* Y2; int Th, row_base;
    __device__ __forceinline__ void operator()(const f32x4 (&acc)[2][2][4][2], const Unit& u, int wr, int wc, int fr, int fq) const {
        const int g = u.pn >> 1, c0 = (u.pn & 1) * 256;
#pragma unroll
        for (int ai = 0; ai < 2; ++ai) { const int m0 = u.pm * 256 + ai * HALF, cs = m0 / Th, kt0 = m0 % Th;
            store_half_bf16(acc[ai], Y2 + (size_t)(row_base + u.z * Th + kt0) * DM + g * 1024 + cs * 512 + c0, DM, -1, wr, wc, fr, fq); }
    }
};
struct EpiF2x {
    static constexpr bool PERM = true; bf16_t* MIX;
    __device__ __forceinline__ void operator()(const f32x4 (&acc)[2][2][4][2], const Unit& u, int wr, int wc, int fr, int fq) const {
        const int mir = u.pn >> 1, c0 = (u.pn & 1) * 256;
#pragma unroll
        for (int ai = 0; ai < 2; ++ai) { const int R0 = u.pm * 256 + ai * HALF; int T, tok0, kt0;
            if (R0 < 4096) { T = 256; tok0 = (R0 >> 7) * 256; kt0 = 0; } else { const int Rp = R0 - 4096; T = 2048; tok0 = NPROMPT + (Rp >> 10) * 2048; kt0 = Rp & 1023; }
            const int tok = tok0 + (mir ? T - kt0 : kt0);
            store_half_bf16(acc[ai], MIX + (size_t)tok * DM + DATT + u.z * 512 + c0, mir ? -(long)DM : (long)DM, kt0 == 0 ? 0 : -1, wr, wc, fr, fq); }
    }
};
struct EpiDelta {
    static constexpr bool PERM = true;
    bf16_t* Dl; const float* gate;
    __device__ __forceinline__ void operator()(const f32x4 (&acc)[2][2][4][2], const Unit& u, int wr, int wc, int fr, int fq) const {
        const int bidx = u.pm < 32 ? 0 : 1 + ((u.pm - 32) >> 3);
        const int col0 = u.pn * 256 + wc * 32 + 8 * fq;
        const float* gp = gate + (size_t)bidx * MODW + col0;
        f32x4 gv[2][2];
#pragma unroll
        for (int bj = 0; bj < 2; ++bj)
#pragma unroll
            for (int n = 0; n < 2; ++n) gv[bj][n] = *(const f32x4*)(gp + bj * HALF + 4 * n);
        bf16_t* p0 = Dl + (size_t)(u.pm * 256 + wr * 64 + fr) * DM + col0;
#pragma unroll
        for (int ai = 0; ai < 2; ++ai)
#pragma unroll
            for (int m = 0; m < 4; ++m) { bf16_t* rowp = p0 + (size_t)(ai * HALF + m * 16) * DM;
#pragma unroll
                for (int bj = 0; bj < 2; ++bj) { const f32x4 v0 = acc[ai][bj][m][0] * gv[bj][0], v1 = acc[ai][bj][m][1] * gv[bj][1];
                    u32x4 w; w.x = cvt_pk_bf16(v0[0], v0[1]); w.y = cvt_pk_bf16(v0[2], v0[3]); w.z = cvt_pk_bf16(v1[0], v1[1]); w.w = cvt_pk_bf16(v1[2], v1[3]);
                    *(u32x4*)(rowp + bj * HALF) = w; } }
    }
};
struct EpiSwiglu {
    static constexpr bool PERM = true; bf16_t* ACT;
    static __device__ __forceinline__ float sw(float g, float u) { return g * __builtin_amdgcn_rcpf(1.0f + __builtin_amdgcn_exp2f(-1.4426950408889634f * g)) * u; }
    __device__ __forceinline__ void operator()(const f32x4 (&acc)[2][2][4][2], const Unit& u, int wr, int wc, int fr, int fq) const {
        bf16_t* p0 = ACT + ((size_t)(u.pm * (DFF / 64) + u.pn * 2 + (wc >> 1)) * 256 + wr * 64 + fr) * 64 + (wc & 1) * 32 + 8 * fq;
#pragma unroll
        for (int ai = 0; ai < 2; ++ai)
#pragma unroll
            for (int m = 0; m < 4; ++m) { const f32x4 g0 = acc[ai][0][m][0], g1 = acc[ai][0][m][1], u0 = acc[ai][1][m][0], u1 = acc[ai][1][m][1];
                u32x4 w; w.x = cvt_pk_bf16(sw(g0[0], u0[0]), sw(g0[1], u0[1])); w.y = cvt_pk_bf16(sw(g0[2], u0[2]), sw(g0[3], u0[3]));
                w.z = cvt_pk_bf16(sw(g1[0], u1[0]), sw(g1[1], u1[1])); w.w = cvt_pk_bf16(sw(g1[2], u1[2]), sw(g1[3], u1[3]));
                __builtin_nontemporal_store(w, (u32x4*)(p0 + (size_t)(ai * HALF + m * 16) * 64)); }
    }
};

__device__ __forceinline__ void wht8(float (&a)[8]) {
#pragma unroll
    for (int st = 1; st < 8; st <<= 1)
#pragma unroll
        for (int i = 0; i < 8; ++i) if (!(i & st)) { const float x = a[i], y = a[i | st]; a[i] = x + y; a[i | st] = x - y; }
#pragma unroll
    for (int i = 0; i < 8; ++i) a[i] *= 0.35355339059327373f;
}
struct EpiKV8 {
    static constexpr bool PERM = true; bf16_t* QKV; const float* sA; const float* sW;
    __device__ __forceinline__ void operator()(const f32x4 (&acc)[2][2][4][2], const Unit& u, int wr, int wc, int fr, int fq) const {
        typedef int v4i_ __attribute__((ext_vector_type(4)));
        const int t = u.pn >> 3, colt = (u.pn & 7) * 256, row0 = u.pm * 256 + wr * 64 + fr, col0 = colt + wc * 32 + 8 * fq;
        const float* swp = sW + (size_t)(u.pn - 8) * 256 + wc * 32 + 8 * fq;
        f32x4 sc[2][2];
#pragma unroll
        for (int bj = 0; bj < 2; ++bj)
#pragma unroll
            for (int n = 0; n < 2; ++n) sc[bj][n] = *(const f32x4*)(swp + bj * HALF + 4 * n);
        bf16_t* p0 = QKV + (size_t)t * NTOK * DATT + (size_t)row0 * DATT + col0;
#pragma unroll
        for (int ai = 0; ai < 2; ++ai)
#pragma unroll
            for (int m = 0; m < 4; ++m) { bf16_t* rowp = p0 + (size_t)(ai * HALF + m * 16) * DATT; const float sr = sA[row0 + ai * HALF + m * 16];
#pragma unroll
                for (int bj = 0; bj < 2; ++bj) { const v4i_ i0 = __builtin_bit_cast(v4i_, acc[ai][bj][m][0]), i1 = __builtin_bit_cast(v4i_, acc[ai][bj][m][1]); f32x4 v0, v1;
#pragma unroll
                    for (int e = 0; e < 4; ++e) { v0[e] = (float)i0[e] * (sr * sc[bj][0][e]); v1[e] = (float)i1[e] * (sr * sc[bj][1][e]); }
                    u32x4 w; w.x = cvt_pk_bf16(v0[0], v0[1]); w.y = cvt_pk_bf16(v0[2], v0[3]); w.z = cvt_pk_bf16(v1[0], v1[1]); w.w = cvt_pk_bf16(v1[2], v1[3]);
                    *(u32x4*)(rowp + bj * HALF) = w; } }
    }
};
struct EpiQ8 {
    static constexpr bool PERM = true; bf16_t* Q; const float* sA; const float* sW;
    __device__ __forceinline__ void operator()(const f32x4 (&acc)[2][2][4][2], const Unit& u, int wr, int wc, int fr, int fq) const {
        typedef int v4i_ __attribute__((ext_vector_type(4)));
        const int row0 = u.pm * 256 + wr * 64 + fr, col0 = u.pn * 256 + wc * 32 + 8 * fq;
        f32x4 sc[2][2];
#pragma unroll
        for (int bj = 0; bj < 2; ++bj)
#pragma unroll
            for (int n = 0; n < 2; ++n) sc[bj][n] = *(const f32x4*)(sW + col0 + bj * HALF + 4 * n);
        bf16_t* p0 = Q + (size_t)row0 * DATT + col0;
#pragma unroll
        for (int ai = 0; ai < 2; ++ai)
#pragma unroll
            for (int m = 0; m < 4; ++m) { bf16_t* rowp = p0 + (size_t)(ai * HALF + m * 16) * DATT; const float sr = sA[row0 + ai * HALF + m * 16];
#pragma unroll
                for (int bj = 0; bj < 2; ++bj) { const v4i_ i0 = __builtin_bit_cast(v4i_, acc[ai][bj][m][0]), i1 = __builtin_bit_cast(v4i_, acc[ai][bj][m][1]); f32x4 v0, v1;
#pragma unroll
                    for (int e = 0; e < 4; ++e) { v0[e] = (float)i0[e] * (sr * sc[bj][0][e]); v1[e] = (float)i1[e] * (sr * sc[bj][1][e]); }
                    u32x4 w; w.x = cvt_pk_bf16(v0[0], v0[1]); w.y = cvt_pk_bf16(v0[2], v0[3]); w.z = cvt_pk_bf16(v1[0], v1[1]); w.w = cvt_pk_bf16(v1[2], v1[3]);
                    *(u32x4*)(rowp + bj * HALF) = w; } }
    }
};
struct EpiUT8 {
    static constexpr bool PERM = true; bf16_t* UT; const float* sRow; const float* sCol;
    __device__ __forceinline__ void operator()(const f32x4 (&acc)[2][2][4][2], const Unit& u, int wr, int wc, int fr, int fq) const {
        typedef int v4i_ __attribute__((ext_vector_type(4)));
        const int row0 = u.pm * 256 + wr * 64 + fr, col0 = u.pn * 256 + wc * 32 + 8 * fq;
        f32x4 sc[2][2];
#pragma unroll
        for (int bj = 0; bj < 2; ++bj)
#pragma unroll
            for (int n = 0; n < 2; ++n) sc[bj][n] = *(const f32x4*)(sCol + col0 + bj * HALF + 4 * n);
        bf16_t* p0 = UT + (size_t)row0 * NTOK + col0;
#pragma unroll
        for (int ai = 0; ai < 2; ++ai)
#pragma unroll
            for (int m = 0; m < 4; ++m) { bf16_t* rowp = p0 + (size_t)(ai * HALF + m * 16) * NTOK; const float sr = sRow[row0 + ai * HALF + m * 16];
#pragma unroll
                for (int bj = 0; bj < 2; ++bj) { const v4i_ i0 = __builtin_bit_cast(v4i_, acc[ai][bj][m][0]), i1 = __builtin_bit_cast(v4i_, acc[ai][bj][m][1]); f32x4 v0, v1;
#pragma unroll
                    for (int e = 0; e < 4; ++e) { v0[e] = (float)i0[e] * (sr * sc[bj][0][e]); v1[e] = (float)i1[e] * (sr * sc[bj][1][e]); }
                    u32x4 w; w.x = cvt_pk_bf16(v0[0], v0[1]); w.y = cvt_pk_bf16(v0[2], v0[3]); w.z = cvt_pk_bf16(v1[0], v1[1]); w.w = cvt_pk_bf16(v1[2], v1[3]);
                    *(u32x4*)(rowp + bj * HALF) = w; } }
    }
};
struct EpiDelta8 {
    static constexpr bool PERM = true; bf16_t* Dl; const float* gate; const float* sA; const float* sW;
    __device__ __forceinline__ void operator()(const f32x4 (&acc)[2][2][4][2], const Unit& u, int wr, int wc, int fr, int fq) const {
        typedef int v4i_ __attribute__((ext_vector_type(4)));
        const int bidx = u.pm < 32 ? 0 : 1 + ((u.pm - 32) >> 3);
        const int col0 = u.pn * 256 + wc * 32 + 8 * fq;
        const float* gp = gate + (size_t)bidx * MODW + col0; const float* swp = sW + col0;
        f32x4 gv[2][2];
#pragma unroll
        for (int bj = 0; bj < 2; ++bj)
#pragma unroll
            for (int n = 0; n < 2; ++n) gv[bj][n] = *(const f32x4*)(gp + bj * HALF + 4 * n) * *(const f32x4*)(swp + bj * HALF + 4 * n);
        bf16_t* p0 = Dl + (size_t)(u.pm * 256 + wr * 64 + fr) * DM + col0; const float* sap = sA + (size_t)u.pm * 256 + wr * 64 + fr;
#pragma unroll
        for (int ai = 0; ai < 2; ++ai)
#pragma unroll
            for (int m = 0; m < 4; ++m) { bf16_t* rowp = p0 + (size_t)(ai * HALF + m * 16) * DM; const float sa = sap[ai * HALF + m * 16];
#pragma unroll
                for (int bj = 0; bj < 2; ++bj) { const v4i_ i0 = __builtin_bit_cast(v4i_, acc[ai][bj][m][0]), i1 = __builtin_bit_cast(v4i_, acc[ai][bj][m][1]); f32x4 v0, v1;
#pragma unroll
                    for (int e = 0; e < 4; ++e) { v0[e] = (float)i0[e] * (sa * gv[bj][0][e]); v1[e] = (float)i1[e] * (sa * gv[bj][1][e]); }
                    u32x4 w; w.x = cvt_pk_bf16(v0[0], v0[1]); w.y = cvt_pk_bf16(v0[2], v0[3]); w.z = cvt_pk_bf16(v1[0], v1[1]); w.w = cvt_pk_bf16(v1[2], v1[3]);
                    *(u32x4*)(rowp + bj * HALF) = w; } }
    }
};
struct EpiSwiglu8 {
    static constexpr bool PERM = true; bf16_t* ACT; const float* sA; const float* sW; unsigned* rowmax;
    __device__ __forceinline__ void operator()(const f32x4 (&acc)[2][2][4][2], const Unit& u, int wr, int wc, int fr, int fq) const {
        typedef int v4i_ __attribute__((ext_vector_type(4)));
        bf16_t* p0 = ACT + ((size_t)(u.pm * (DFF / 64) + u.pn * 2 + (wc >> 1)) * 256 + wr * 64 + fr) * 64 + (wc & 1) * 32 + 8 * fq;
        const float* swp = sW + (size_t)u.pn * 256 + wc * 32 + 8 * fq;
        const f32x4 sg0 = *(const f32x4*)swp, sg1 = *(const f32x4*)(swp + 4), su0 = *(const f32x4*)(swp + HALF), su1 = *(const f32x4*)(swp + HALF + 4);
        const int row0 = u.pm * 256 + wr * 64 + fr; const float* sap = sA + row0;
#pragma unroll
        for (int ai = 0; ai < 2; ++ai)
#pragma unroll
            for (int m = 0; m < 4; ++m) { const float sa = sap[ai * HALF + m * 16];
                const v4i_ ig0 = __builtin_bit_cast(v4i_, acc[ai][0][m][0]), ig1 = __builtin_bit_cast(v4i_, acc[ai][0][m][1]), iu0 = __builtin_bit_cast(v4i_, acc[ai][1][m][0]), iu1 = __builtin_bit_cast(v4i_, acc[ai][1][m][1]);
                float a[8];
#pragma unroll
                for (int e = 0; e < 4; ++e) { a[e] = EpiSwiglu::sw((float)ig0[e] * (sa * sg0[e]), (float)iu0[e] * (sa * su0[e])); a[4 + e] = EpiSwiglu::sw((float)ig1[e] * (sa * sg1[e]), (float)iu1[e] * (sa * su1[e])); }
                wht8(a);
                u32x4 w; w.x = cvt_pk_bf16(a[0], a[1]); w.y = cvt_pk_bf16(a[2], a[3]); w.z = cvt_pk_bf16(a[4], a[5]); w.w = cvt_pk_bf16(a[6], a[7]);
                *(u32x4*)(p0 + (size_t)(ai * HALF + m * 16) * 64) = w;
                float mx = fmaxf(fmaxf(fmaxf(fabsf(a[0]), fabsf(a[1])), fmaxf(fabsf(a[2]), fabsf(a[3]))), fmaxf(fmaxf(fabsf(a[4]), fabsf(a[5])), fmaxf(fabsf(a[6]), fabsf(a[7]))));
                mx = fmaxf(mx, __shfl_xor(mx, 16)); mx = fmaxf(mx, __shfl_xor(mx, 32));
                if (fq == 0) __hip_atomic_fetch_max(rowmax + row0 + ai * HALF + m * 16, cvt_pk_bf16(mx, mx) << 16, __ATOMIC_RELAXED, __HIP_MEMORY_SCOPE_AGENT); }
    }
};

template <class Epi, class Sched, bool ALIGN_EPI, bool I8 = false>
__device__ __forceinline__ void gemm_phase(PG8_LAS unsigned char* lds, const Gemm g, const Sched& S, const Epi& E) {
    const int tid = threadIdx.x, wid = __builtin_amdgcn_readfirstlane(tid >> 6), lane = tid & 63, wr = wid >> 2, wc = wid & 3, fr = lane & 15, fq = lane >> 4;
    const int K = g.K, nt = K / BK;
    unsigned voffA[2], voffB[2];
#pragma unroll
    for (int i = 0; i < 2; ++i) { int R, C; stage_rc(tid * 16 + i * 8192, R, C); const int Rb = Epi::PERM ? ((R & ~31) + perm32(R & 31)) : R;
        voffA[i] = (unsigned)(R * g.lda + C) * 2u; voffB[i] = (unsigned)(Rb * g.ldb + C) * 2u; }
    const size_t kstepA = g.kstepA, kstepB = g.kstepB, hstepA = g.hstepA, hstepB = g.hstepB;
    const unsigned ldsw = (unsigned)wid * 1024u;
    const int aoff = lds_byte(wr * 64 + fr, fq * 8), boff = lds_byte(wc * 32 + fr, fq * 8);
#define PG8_SA(b, h) (((b) * 2 + (h)) * HTB)
#define PG8_SB(b, h) ((4 + (b) * 2 + (h)) * HTB)
#define PG8_STAGE(bufoff, gbase, voff) do { _Pragma("unroll") for (int _i = 0; _i < 2; ++_i) \
        __builtin_amdgcn_global_load_lds((const unsigned*)((const char*)(gbase) + (voff)[_i]), (PG8_LAS unsigned*)(lds + (bufoff) + ldsw + _i * 8192), 16, 0, 0); } while (0)
#define PG8_STAGEB(bufoff, gbase, voff) do { _Pragma("unroll") for (int _i = 0; _i < 2; ++_i) \
        __builtin_amdgcn_global_load_lds((const unsigned*)((const char*)(gbase) + (voff)[_i]), (PG8_LAS unsigned*)(lds + (bufoff) + ldsw + _i * 8192), 16, 0, 0); } while (0)
#define PG8_LDA(dst, b, h) do { _Pragma("unroll") for (int m = 0; m < 4; ++m) _Pragma("unroll") for (int k = 0; k < 2; ++k) dst[m][k] = *(const PG8_LAS bf16x8*)(lds + PG8_SA(b, h) + aoff + m * 2048 + k * 1024); } while (0)
#define PG8_LDB(dst, b, h) do { _Pragma("unroll") for (int n = 0; n < 2; ++n) _Pragma("unroll") for (int k = 0; k < 2; ++k) dst[n][k] = *(const PG8_LAS bf16x8*)(lds + PG8_SB(b, h) + boff + n * 2048 + k * 1024); } while (0)
#define PG8_MMA(ai, bj, At, Bt) do { __builtin_amdgcn_s_setprio(1); _Pragma("unroll") for (int m = 0; m < 4; ++m) _Pragma("unroll") for (int n = 0; n < 2; ++n) _Pragma("unroll") for (int k = 0; k < 2; ++k) { \
        if constexpr (I8) { typedef int v4i_ __attribute__((ext_vector_type(4))); \
            acc[ai][bj][m][n] = __builtin_bit_cast(f32x4, __builtin_amdgcn_mfma_i32_16x16x64_i8(__builtin_bit_cast(v4i_, Bt[n][k]), __builtin_bit_cast(v4i_, At[m][k]), __builtin_bit_cast(v4i_, acc[ai][bj][m][n]), 0, 0, 0)); } \
        else acc[ai][bj][m][n] = __builtin_amdgcn_mfma_f32_16x16x32_bf16(Bt[n][k], At[m][k], acc[ai][bj][m][n], 0, 0, 0); } __builtin_amdgcn_s_setprio(0); } while (0)
#define PG8_WAIT_V(n) asm volatile("s_waitcnt vmcnt(" #n ")" ::: "memory")
#define PG8_WAIT_L(n) asm volatile("s_waitcnt lgkmcnt(" #n ")" ::: "memory")
#define PG8_BAR __builtin_amdgcn_s_barrier()
#define PG8_SCHED __builtin_amdgcn_sched_barrier(0)
    Unit cur, nxt; int ui = 0;
    if (!S.next(0, cur)) return;
    f32x4 acc[2][2][4][2];
#pragma unroll
    for (int a = 0; a < 2; ++a)
#pragma unroll
        for (int b = 0; b < 2; ++b)
#pragma unroll
            for (int m = 0; m < 4; ++m)
#pragma unroll
                for (int n = 0; n < 2; ++n) acc[a][b][m][n] = (f32x4){0.f, 0.f, 0.f, 0.f};
    bf16x8 At[4][2], B0[2][2], B1[2][2];
    const char* cA = cur.a; const char* cB = cur.b;
    PG8_STAGEB(PG8_SB(0, 0), cB, voffB); PG8_STAGEB(PG8_SB(0, 1), cB + hstepB, voffB); PG8_STAGE(PG8_SA(0, 0), cA, voffA); PG8_STAGE(PG8_SA(0, 1), cA + hstepA, voffA);
    if (wr == 1) PG8_BAR;
    PG8_WAIT_V(2); PG8_BAR;
    PG8_STAGEB(PG8_SB(1, 0), cB + kstepB, voffB); PG8_STAGE(PG8_SA(1, 0), cA + kstepA, voffA); PG8_STAGEB(PG8_SB(1, 1), cB + hstepB + kstepB, voffB);
    PG8_WAIT_V(6); PG8_BAR;
    for (;;) {
        const bool has_next = S.next(ui + 1, nxt);
        const char* nA = has_next ? nxt.a : cA; const char* nB = has_next ? nxt.b : cB;
        for (int t = 0; t < nt; t += 2) {
            const bool last = (t == nt - 2);
            const char* a1 = cA + (size_t)(t + 1) * kstepA;
            const char* a2 = last ? nA : cA + (size_t)(t + 2) * kstepA; const char* b2 = last ? nB : cB + (size_t)(t + 2) * kstepB;
            const char* a3 = a2 + kstepA; const char* b3 = b2 + kstepB;
            PG8_LDB(B0, 0, 0); PG8_LDB(B1, 0, 1); PG8_SCHED; PG8_LDA(At, 0, 0); PG8_STAGE(PG8_SA(1, 1), a1 + hstepA, voffA);
            PG8_WAIT_V(8); PG8_WAIT_L(0); PG8_BAR; PG8_MMA(0, 0, At, B0); PG8_MMA(0, 1, At, B1); PG8_BAR; PG8_SCHED;
            PG8_LDA(At, 0, 1); PG8_STAGEB(PG8_SB(0, 0), b2, voffB); PG8_STAGEB(PG8_SB(0, 1), b2 + hstepB, voffB); PG8_STAGE(PG8_SA(0, 0), a2, voffA);
            PG8_WAIT_V(8); PG8_WAIT_L(0); PG8_BAR; PG8_MMA(1, 0, At, B0); PG8_MMA(1, 1, At, B1); PG8_BAR; PG8_SCHED;
            PG8_LDB(B0, 1, 0); PG8_LDB(B1, 1, 1); PG8_SCHED; PG8_LDA(At, 1, 0); PG8_STAGE(PG8_SA(0, 1), a2 + hstepA, voffA);
            PG8_WAIT_V(8); PG8_WAIT_L(0); PG8_BAR; PG8_MMA(0, 0, At, B0); PG8_MMA(0, 1, At, B1); PG8_BAR; PG8_SCHED;
            PG8_LDA(At, 1, 1); PG8_STAGEB(PG8_SB(1, 0), b3, voffB); PG8_STAGEB(PG8_SB(1, 1), b3 + hstepB, voffB); PG8_STAGE(PG8_SA(1, 0), a3, voffA);
            PG8_WAIT_V(8); PG8_WAIT_L(0); PG8_BAR; PG8_MMA(1, 0, At, B0); PG8_MMA(1, 1, At, B1); PG8_BAR; PG8_SCHED;
        }
        if constexpr (ALIGN_EPI) { if (wr == 0) PG8_BAR; }
        E(acc, cur, wr, wc, fr, fq);
        if (!has_next) break;
#pragma unroll
        for (int a = 0; a < 2; ++a)
#pragma unroll
            for (int b = 0; b < 2; ++b)
#pragma unroll
                for (int m = 0; m < 4; ++m)
#pragma unroll
                    for (int n = 0; n < 2; ++n) acc[a][b][m][n] = (f32x4){0.f, 0.f, 0.f, 0.f};
        cur = nxt; cA = nA; cB = nB; ++ui;
        if constexpr (ALIGN_EPI) { if (wr == 1) PG8_BAR; }
    }
    PG8_WAIT_V(0);
    if constexpr (!ALIGN_EPI) { if (wr == 0) PG8_BAR; }
    PG8_BAR;
#undef PG8_SA
#undef PG8_SB
#undef PG8_STAGE
#undef PG8_STAGEB
#undef PG8_LDA
#undef PG8_LDB
#undef PG8_MMA
#undef PG8_WAIT_V
#undef PG8_WAIT_L
#undef PG8_BAR
#undef PG8_SCHED
}
}

namespace att {
using bf16x8 = __attribute__((ext_vector_type(8))) short;
using s16x4  = __attribute__((ext_vector_type(4))) short;
using f32x16 = __attribute__((ext_vector_type(16))) float;
using u32x4  = __attribute__((ext_vector_type(4))) unsigned;
constexpr int D = 128, NW = 8, QBLK = 32, KVBLK = 64;
constexpr float SCALE = 0.088388347648318440f;
constexpr float THR = 8.f;
constexpr int LDQ = DATT, LDK = DATT, LDO = DM;
constexpr size_t SHM_V = KVBLK * D * 2, SHM_K = KVBLK * D * 2;
constexpr int OFF_WS = 2 * SHM_V + 2 * SHM_K, OFF_TAB = OFF_WS + NW * 64 * 4, OFF_OST = OFF_TAB + 15 * 128 * 4, OST_PITCH = 272, OST_WAVE = 32 * OST_PITCH, SHM_ATTN = OFF_OST + NW * OST_WAVE;
constexpr float NEG = -1e30f, M_INIT = -1e4f;
#define KSWZ(row, colB) ((row) * 256 + ((colB) ^ (((row) & 7) << 4)))
#define SBAR() __builtin_amdgcn_sched_barrier(0)
__device__ __forceinline__ int crow(int r, int hi) { return (r & 3) + 8 * (r >> 2) + 4 * hi; }
__device__ __forceinline__ unsigned cvtpk(float lo, float hi) { unsigned r; asm volatile("v_cvt_pk_bf16_f32 %0, %1, %2" : "=v"(r) : "v"(lo), "v"(hi)); return r; }

__device__ __forceinline__ void partialSM(f32x16& p0, f32x16& p1, float& m_reg, float& mn, float& alpha) {
  constexpr float C = SCALE * 1.4426950408889634f;
  float pmax = p0[0];
#pragma unroll
  for (int r = 1; r < 16; ++r) pmax = fmaxf(pmax, p0[r]);
#pragma unroll
  for (int r = 0; r < 16; ++r) pmax = fmaxf(pmax, p1[r]);
  { auto rr = __builtin_amdgcn_permlane32_swap(__float_as_uint(pmax), __float_as_uint(pmax), false, false);
    pmax = fmaxf(__uint_as_float(rr[0]), __uint_as_float(rr[1])); }
  if (__builtin_expect(__all(pmax - m_reg <= THR / SCALE), 1)) { mn = m_reg; alpha = 1.f; }
  else { mn = fmaxf(m_reg, pmax); alpha = __builtin_amdgcn_exp2f((m_reg - mn) * C); m_reg = mn; }
  float mnC = -mn * C;
#pragma unroll
  for (int r = 0; r < 16; ++r) p0[r] = fmaf(p0[r], C, mnC);
#pragma unroll
  for (int r = 0; r < 16; ++r) p1[r] = fmaf(p1[r], C, mnC);
#pragma unroll
  for (int r = 0; r < 16; ++r) p0[r] = __builtin_amdgcn_exp2f(p0[r]);
}
__device__ __forceinline__ void finishSM(f32x16& p0, f32x16& p1, float alpha, float& l_reg, bf16x8& pa0, bf16x8& pa1, bf16x8& pa2, bf16x8& pa3) {
#pragma unroll
  for (int r = 0; r < 16; ++r) p1[r] = __builtin_amdgcn_exp2f(p1[r]);
  float ps = 0;
#pragma unroll
  for (int r = 0; r < 16; ++r) ps += p0[r];
#pragma unroll
  for (int r = 0; r < 16; ++r) ps += p1[r];
  { auto rr = __builtin_amdgcn_permlane32_swap(__float_as_uint(ps), __float_as_uint(ps), false, false);
    ps = __uint_as_float(rr[0]) + __uint_as_float(rr[1]); }
  l_reg = l_reg * alpha + ps;
#define PK4(P, BASE, OUT) do { unsigned a0 = cvtpk(P[BASE + 0], P[BASE + 1]), a1 = cvtpk(P[BASE + 2], P[BASE + 3]);   \
    unsigned b0 = cvtpk(P[BASE + 4], P[BASE + 5]), b1 = cvtpk(P[BASE + 6], P[BASE + 7]);                              \
    auto r0 = __builtin_amdgcn_permlane32_swap(a0, b0, false, false); auto r1 = __builtin_amdgcn_permlane32_swap(a1, b1, false, false); \
    u32x4 w = {r0[0], r1[0], r0[1], r1[1]}; OUT = *reinterpret_cast<bf16x8*>(&w); } while (0)
  PK4(p0, 0, pa0); PK4(p0, 8, pa1); PK4(p1, 0, pa2); PK4(p1, 8, pa3);
#undef PK4
}
__device__ __forceinline__ void qkt(f32x16& p0, f32x16& p1, const char* Ks, const bf16x8* qr, int r32, int hi) {
  p0 = f32x16{}; p1 = f32x16{};
#pragma unroll
  for (int d0 = 0; d0 < 8; ++d0) { int cb = (d0 * 16 + hi * 8) * 2;
    bf16x8 b0 = *reinterpret_cast<const bf16x8*>(Ks + KSWZ(r32, cb));
    bf16x8 b1 = *reinterpret_cast<const bf16x8*>(Ks + KSWZ(32 + r32, cb));
    p0 = __builtin_amdgcn_mfma_f32_32x32x16_bf16(b0, qr[d0], p0, 0, 0, 0);
    p1 = __builtin_amdgcn_mfma_f32_32x32x16_bf16(b1, qr[d0], p1, 0, 0, 0); }
}
__device__ __forceinline__ int v_st(int k, int c) { const int kk = (k & ~0xC) | ((k & 4) << 1) | ((k & 8) >> 1); return ((kk >> 3) * 4 + (c >> 5)) * 512 + ((kk & 7) * 32 + (c & 31)) * 2; }
__device__ __forceinline__ int v_rd_base(int lane) { return ((lane & 3) << 3) | (((lane >> 2) & 3) << 6) | (((lane >> 4) & 1) << 5) | (((lane >> 5) & 1) << 8); }
constexpr int v_rd_off(int d0, int ks, int half) { return d0 * 512 + ks * 4096 + half * 2048; }
template <int OFF> __device__ __forceinline__ s16x4 tr_read(int vb) {
  s16x4 r; asm volatile("ds_read_b64_tr_b16 %0, %1 offset:%2" : "=&v"(r) : "v"(vb), "i"(OFF) : "memory"); return r;
}
template <int D0> __device__ __forceinline__ void pv_one(f32x16& od, int vb, bf16x8 pa0, bf16x8 pa1, bf16x8 pa2, bf16x8 pa3) {
  const s16x4 l0 = tr_read<v_rd_off(D0, 0, 0)>(vb), h0 = tr_read<v_rd_off(D0, 0, 1)>(vb), l1 = tr_read<v_rd_off(D0, 1, 0)>(vb), h1 = tr_read<v_rd_off(D0, 1, 1)>(vb);
  const s16x4 l2 = tr_read<v_rd_off(D0, 2, 0)>(vb), h2 = tr_read<v_rd_off(D0, 2, 1)>(vb), l3 = tr_read<v_rd_off(D0, 3, 0)>(vb), h3 = tr_read<v_rd_off(D0, 3, 1)>(vb);
  asm volatile("s_waitcnt lgkmcnt(0)" ::: "memory"); SBAR();
#define PK(L, H) (bf16x8){L[0], L[1], L[2], L[3], H[0], H[1], H[2], H[3]}
  od = __builtin_amdgcn_mfma_f32_32x32x16_bf16(pa0, PK(l0, h0), od, 0, 0, 0);
  od = __builtin_amdgcn_mfma_f32_32x32x16_bf16(pa1, PK(l1, h1), od, 0, 0, 0);
  od = __builtin_amdgcn_mfma_f32_32x32x16_bf16(pa2, PK(l2, h2), od, 0, 0, 0);
  od = __builtin_amdgcn_mfma_f32_32x32x16_bf16(pa3, PK(l3, h3), od, 0, 0, 0);
#undef PK
}
__device__ __forceinline__ void pv_d0(f32x16* o, int vb, bf16x8 pa0, bf16x8 pa1, bf16x8 pa2, bf16x8 pa3) {
  pv_one<0>(o[0], vb, pa0, pa1, pa2, pa3); pv_one<1>(o[1], vb, pa0, pa1, pa2, pa3); pv_one<2>(o[2], vb, pa0, pa1, pa2, pa3); pv_one<3>(o[3], vb, pa0, pa1, pa2, pa3);
}

struct AttnUnit { const bf16* Q; const bf16* K0; const bf16* V0; const bf16* K1; const bf16* V1; bf16* O; const float* rpbh; int n0, n1, r0, kr0; };

template <bool NEIGH>
__device__ __forceinline__ void attn_unit(const AttnUnit& U, char* lds) {
  const int tid = threadIdx.x, wid = tid >> 6, lane = tid & 63, r32 = lane & 31, hi = lane >> 5;
  char* V_lds = lds; char* K_lds = lds + 2 * SHM_V;
  float* ws = (float*)(lds + OFF_WS) + wid * 64; float* li_l = ws; float* al_l = ws + 32;
  float* tab = (float*)(lds + OFF_TAB);
  __syncthreads();
  if (NEIGH) { for (int i = tid; i < 15 * 128; i += 512) { const int dr = i >> 7, dc = (i & 127) - 48; tab[i] = (dc >= 0 && dc < 31) ? U.rpbh[dr * 31 + dc] * (1.0f / SCALE) : 0.f; } }
  float m_reg = M_INIT, l_reg = 0; f32x16 o[4] = {}; bf16x8 qr[8];
  const bf16* Qw = U.Q + (long)(wid * QBLK + r32) * LDQ + hi * 8;
#pragma unroll
  for (int d0 = 0; d0 < 8; ++d0) qr[d0] = *reinterpret_cast<const bf16x8*>(Qw + d0 * 16);
  const int sr = tid >> 4, sc = (tid & 15) * 8, vst0 = v_st(sr, sc), vst1 = v_st(32 + sr, sc);
  const int vb0 = (int)(uintptr_t)V_lds + v_rd_base(lane);
  const int qrow = U.r0 + (wid >> 1), rs = min(max(qrow - 4, 0), 24), qc = (wid & 1) * 32 + r32, cs = min(max(qc - 8, 0), 48);
  struct { bf16x8 vs0, vs1, ks0, ks1; } sr_[2];
  const int n0 = U.n0, NT = U.n0 + U.n1;
#define KPTR(j) ((j) < n0 ? U.K0 + (long)(j) * KVBLK * LDK : U.K1 + (long)((j) - n0) * KVBLK * LDK)
#define VPTR(j) ((j) < n0 ? U.V0 + (long)(j) * KVBLK * LDK : U.V1 + (long)((j) - n0) * KVBLK * LDK)
#define SLOAD(i, j) do { const bf16* kp_ = KPTR(j); const bf16* vp_ = VPTR(j); \
    sr_[i].vs0 = *reinterpret_cast<const bf16x8*>(&vp_[(long)sr * LDK + sc]); sr_[i].vs1 = *reinterpret_cast<const bf16x8*>(&vp_[(long)(32 + sr) * LDK + sc]); \
    sr_[i].ks0 = *reinterpret_cast<const bf16x8*>(&kp_[(long)sr * LDK + sc]); sr_[i].ks1 = *reinterpret_cast<const bf16x8*>(&kp_[(long)(32 + sr) * LDK + sc]); } while (0)
#define SWRITE(b, i) do { *(bf16x8*)(V_lds + (b) * SHM_V + vst0) = sr_[i].vs0; *(bf16x8*)(V_lds + (b) * SHM_V + vst1) = sr_[i].vs1; int kc = sc * 2; \
    *(bf16x8*)(K_lds + (b) * SHM_K + KSWZ(sr, kc)) = sr_[i].ks0; *(bf16x8*)(K_lds + (b) * SHM_K + KSWZ(32 + sr, kc)) = sr_[i].ks1; } while (0)
#define SWAIT() asm volatile("s_waitcnt vmcnt(4)" ::: "memory")
#define RESC(a) do { if (__any((a) < 1.f)) { if (hi == 0) al_l[r32] = (a); asm volatile("s_waitcnt lgkmcnt(0)" ::: "memory"); \
    _Pragma("unroll") for (int d = 0; d < 4; ++d) _Pragma("unroll") for (int r = 0; r < 16; ++r) o[d][r] *= al_l[crow(r, hi)]; } } while (0)
#define BIASMASK(P0, P1, j) do { if (NEIGH && (j) < n0) { const int kr_ = U.kr0 + (j); \
    if ((unsigned)(kr_ - rs) < 8u) { const float* trow_ = tab + (kr_ - qrow + 7) * 128 + (63 - qc + 4 * hi); const int cb_ = 4 * hi - cs; \
      _Pragma("unroll") for (int r = 0; r < 16; ++r) { const int kc_ = (r & 3) + 8 * (r >> 2); \
        P0[r] = ((unsigned)(cb_ + kc_) < 16u) ? P0[r] + trow_[kc_] : NEG; \
        P1[r] = ((unsigned)(cb_ + kc_ + 32) < 16u) ? P1[r] + trow_[kc_ + 32] : NEG; \
        if ((r & 3) == 3) asm volatile("" ::: "memory"); } } \
    else { _Pragma("unroll") for (int r = 0; r < 16; ++r) { P0[r] = NEG; P1[r] = NEG; } } } } while (0)
  f32x16 pA0, pA1, pB0, pB1; float mnA, mnB, alA, alB; bf16x8 pa0, pa1, pa2, pa3;
  constexpr int SE = 0, SO = 1;
  SLOAD(SE, 0); asm volatile("s_waitcnt vmcnt(0)" ::: "memory"); SWRITE(0, SE); __syncthreads();
  qkt(pA0, pA1, K_lds, qr, r32, hi); BIASMASK(pA0, pA1, 0); partialSM(pA0, pA1, m_reg, mnA, alA);
  SLOAD(SO, 1); if (2 < NT) SLOAD(SE, 2);
  SWAIT(); SWRITE(1, SO); __syncthreads();
  for (int j = 1; j + 1 < NT; j += 2) {
    SBAR(); qkt(pB0, pB1, K_lds + SHM_K, qr, r32, hi);
    finishSM(pA0, pA1, alA, l_reg, pa0, pa1, pa2, pa3); SBAR();
    SLOAD(SO, j + 2); SBAR();
    pv_d0(o, vb0, pa0, pa1, pa2, pa3); BIASMASK(pB0, pB1, j); partialSM(pB0, pB1, m_reg, mnB, alB);
    __syncthreads(); SWAIT(); SWRITE(0, SE);
    RESC(alB); __syncthreads();
    SBAR(); qkt(pA0, pA1, K_lds, qr, r32, hi);
    finishSM(pB0, pB1, alB, l_reg, pa0, pa1, pa2, pa3); SBAR();
    if (j + 3 < NT) SLOAD(SE, j + 3); SBAR();
    pv_d0(o, vb0 + (int)SHM_V, pa0, pa1, pa2, pa3); BIASMASK(pA0, pA1, j + 1); partialSM(pA0, pA1, m_reg, mnA, alA);
    __syncthreads(); SWAIT(); SWRITE(1, SO);
    RESC(alA); __syncthreads();
  }
  SBAR(); qkt(pB0, pB1, K_lds + SHM_K, qr, r32, hi);
  finishSM(pA0, pA1, alA, l_reg, pa0, pa1, pa2, pa3); SBAR();
  pv_d0(o, vb0, pa0, pa1, pa2, pa3); BIASMASK(pB0, pB1, NT - 1); partialSM(pB0, pB1, m_reg, mnB, alB);
  __syncthreads(); RESC(alB);
  finishSM(pB0, pB1, alB, l_reg, pa0, pa1, pa2, pa3); SBAR();
  pv_d0(o, vb0 + (int)SHM_V, pa0, pa1, pa2, pa3);
  if (hi == 0) li_l[r32] = l_reg; asm volatile("s_waitcnt lgkmcnt(0)" ::: "memory");
  float rli[16];
#pragma unroll
  for (int r = 0; r < 16; ++r) rli[r] = __builtin_amdgcn_rcpf(li_l[crow(r, hi)]);
  char* ost = lds + OFF_OST + wid * OST_WAVE;
#pragma unroll
  for (int r = 0; r < 16; ++r) { const int orow = crow(r, hi);
#pragma unroll
    for (int d0 = 0; d0 < 4; ++d0) { const float v = o[d0][r] * rli[r]; *(bf16*)(ost + orow * OST_PITCH + (d0 * 32 + r32) * 2) = (bf16)(cvtpk(v, v) & 0xffffu); } }
  asm volatile("s_waitcnt lgkmcnt(0)" ::: "memory");
  { bf16* Ow = U.O + (long)(wid * QBLK + (lane >> 4)) * LDO + (lane & 15) * 8; const char* osr = ost + (lane >> 4) * OST_PITCH + (lane & 15) * 16;
#pragma unroll 1
    for (int i = 0; i < 8; ++i) { *(u32x4*)Ow = *(const u32x4*)osr; Ow += 4 * LDO; osr += 4 * OST_PITCH; } }
#undef KPTR
#undef VPTR
#undef SLOAD
#undef SWRITE
#undef SWAIT
#undef RESC
#undef BIASMASK
}
}
static_assert(att::SHM_ATTN <= LDSCTL_OFF, "attention LDS stays below the control words");

#define XB_TMO      128
#define XB_XCNT(j)  (256  + 64 * (j))
#define XB_XSUB(j)  (1280 + 64 * (j))
#define XB_XGEN(j)  (2304 + 64 * (j))
#define XB_TOP      3328
#define XB_TOPGEN   3392
#define XCD_BAR_WORDS 3456
#define XB_SPIN_CAP (1u << 18)
__device__ __forceinline__ unsigned xb_ld(unsigned* p)              { return __hip_atomic_load(p, __ATOMIC_RELAXED, __HIP_MEMORY_SCOPE_AGENT); }
__device__ __forceinline__ unsigned xb_add(unsigned* p, unsigned v) { return __hip_atomic_fetch_add(p, v, __ATOMIC_RELAXED, __HIP_MEMORY_SCOPE_AGENT); }
__device__ __forceinline__ unsigned xb_xcc_id() { return (unsigned)__builtin_amdgcn_s_getreg((3 << 11) | 20) & 0xFu; }
#define XB_SPIN(cond, bar) do { unsigned _sp = 0; while (cond) { __builtin_amdgcn_s_sleep(1); \
    if ((++_sp & 255u) == 0u) { if (xb_ld(&(bar)[XB_TMO])) break; if (_sp > XB_SPIN_CAP) { atomicAdd(&(bar)[XB_TMO], 1u); break; } } } } while (0)
struct XcdBarrier { unsigned* bar; unsigned x; volatile LAS unsigned* st; };
__device__ __forceinline__ XcdBarrier xcd_barrier_post(unsigned* bar, volatile LAS unsigned* st) {
    XcdBarrier b; b.bar = bar; b.x = xb_xcc_id(); b.st = st;
    if (threadIdx.x == 0) (void)xb_add(&bar[XB_XCNT(b.x)], 1u);
    return b;
}
__device__ __forceinline__ void xcd_barrier_complete(unsigned* bar, unsigned x, unsigned& nloc, unsigned& nx) {
    const unsigned G = gridDim.x * gridDim.y * gridDim.z;
    unsigned sum, cnt, mine, sp = 0u;
    for (;;) {
        sum = 0u; cnt = 0u; mine = 0u;
#pragma unroll
        for (unsigned j = 0; j < 16; ++j) { const unsigned c = xb_ld(&bar[XB_XCNT(j)]); sum += c; cnt += (c > 0u) ? 1u : 0u; mine = (j == x) ? c : mine; }
        if (sum == G) break;
        __builtin_amdgcn_s_sleep(1);
        if ((++sp & 255u) == 0u) { if (xb_ld(&bar[XB_TMO])) break; if (sp > XB_SPIN_CAP) { atomicAdd(&bar[XB_TMO], 1u); break; } }
    }
    nloc = mine > 0u ? mine : 1u; nx = cnt > 0u ? cnt : 1u;
}
__device__ __forceinline__ void xcd_barrier(const XcdBarrier& b) {
    asm volatile("s_waitcnt vmcnt(0)" ::: "memory");
    __syncthreads();
    if (threadIdx.x == 0) {
        unsigned* bar = b.bar;
        __builtin_amdgcn_s_waitcnt(0);
        unsigned nloc = b.st[0], nx = b.st[1];
        if (nloc == 0u) { xcd_barrier_complete(bar, b.x, nloc, nx); b.st[0] = nloc; b.st[1] = nx; }
        const unsigned old = xb_add(&bar[XB_XSUB(b.x)], 1u);
        const unsigned gen = old / nloc;
        if (old + 1u == (gen + 1u) * nloc) {
            __builtin_amdgcn_fence(__ATOMIC_RELEASE, "agent");
            asm volatile("s_waitcnt vmcnt(0)" ::: "memory");
            const unsigned og = xb_add(&bar[XB_TOP], 1u);
            const unsigned tg = og / nx;
            if (og + 1u == (tg + 1u) * nx) xb_add(&bar[XB_TOPGEN], 1u);
            else XB_SPIN(xb_ld(&bar[XB_TOPGEN]) == tg, bar);
            __builtin_amdgcn_fence(__ATOMIC_ACQUIRE, "agent");
            xb_add(&bar[XB_XGEN(b.x)], 1u);
            asm volatile("s_waitcnt vmcnt(0)" ::: "memory");
        } else {
            XB_SPIN(xb_ld(&bar[XB_XGEN(b.x)]) == gen, bar);
            __builtin_amdgcn_fence(__ATOMIC_ACQUIRE, "agent");
            asm volatile("s_waitcnt vmcnt(0)" ::: "memory");
        }
    }
    __syncthreads();
}

typedef float f32x4 __attribute__((ext_vector_type(4)));
__device__ __forceinline__ unsigned f2bf(float f) { unsigned u = __builtin_bit_cast(unsigned, f); return (u + 0x7fffu + ((u >> 16) & 1u)) >> 16; }
__device__ __forceinline__ unsigned pk2(float lo, float hi) { return f2bf(lo) | (f2bf(hi) << 16); }
__device__ __forceinline__ float wave_sum(float v) {
#pragma unroll
    for (int o = 1; o < 64; o <<= 1) v += __shfl_xor(v, o);
    return v;
}

__device__ __forceinline__ unsigned q8x4(float a, float b, float c, float d, float iv) {
    unsigned r = 0u;
    r = __builtin_amdgcn_cvt_pk_u8_f32(__builtin_rintf(a * iv + 128.0f), 0, r); r = __builtin_amdgcn_cvt_pk_u8_f32(__builtin_rintf(b * iv + 128.0f), 1, r);
    r = __builtin_amdgcn_cvt_pk_u8_f32(__builtin_rintf(c * iv + 128.0f), 2, r); r = __builtin_amdgcn_cvt_pk_u8_f32(__builtin_rintf(d * iv + 128.0f), 3, r);
    return r ^ 0x80808080u;
}
__device__ __forceinline__ f32x4 add_bf4(f32x4 v, v2u d) {
    v.x += __uint_as_float(d.x << 16); v.y += __uint_as_float(d.x & 0xffff0000u); v.z += __uint_as_float(d.y << 16); v.w += __uint_as_float(d.y & 0xffff0000u); return v; }

struct Args {
    const float *x_prompt, *x_sample, *cache_k, *cache_v, *c, *c_ctx, *w_ada, *b_ada, *norm1_g, *w_in, *rpb, *w_out, *norm2_g, *w_gate, *w_up, *w_down, *final_g;
    float* out; unsigned char* ws; int ph_lo, ph_hi;
};

struct TrItem { const float* W; bf16* WT; int N, k0, n0, drow0, dcol; unsigned ldT; bool nt; };
constexpr int TR_I_IN = 64 * 64, TR_I_OUT = 64 * 64, TR_I_G = 64 * 172, TR_I_D = 172 * 64, TR_NITEMS = TR_I_IN + TR_I_OUT + 2 * TR_I_G + TR_I_D;
__device__ __forceinline__ TrItem tr_decode(const Args& args, bf16* WinT, bf16* WoutT, bf16* WguT, bf16* WdT, int r) {
    TrItem t;
    if (r < TR_I_IN) { const int kb = r / 64, nb = 32 + r % 64; t.W = args.w_in;
        t.N = 8192; t.k0 = kb * 64; t.n0 = nb * 64; t.WT = WinT; t.ldT = DM; t.drow0 = nb * 64; t.dcol = t.k0; t.nt = false; return t; } r -= TR_I_IN;
    if (r < TR_I_OUT) { const int kb = r / 64, nb = r % 64; t.W = args.w_out; t.N = DM; t.k0 = kb * 64; t.n0 = nb * 64; t.WT = WoutT; t.ldT = DM; t.drow0 = nb * 64; t.dcol = t.k0; t.nt = true; return t; } r -= TR_I_OUT;
    if (r < 2 * TR_I_G) { const bool up = r >= TR_I_G; if (up) r -= TR_I_G; const int kb = r / 172, nb = r % 172, n0 = nb * 64;
        t.W = up ? args.w_up : args.w_gate; t.N = DFF; t.k0 = kb * 64; t.n0 = n0; t.WT = WguT; t.ldT = DM; t.drow0 = (n0 >> 7) * 256 + (n0 & 127) + (up ? 128 : 0); t.dcol = t.k0; t.nt = true; return t; } r -= 2 * TR_I_G;
    { const int kb = r / 64, nb = r % 64; t.W = args.w_down; t.N = DM; t.k0 = kb * 64; t.n0 = nb * 64; t.WT = WdT + ((size_t)((nb >> 2) * (DFF / 64) + kb) * 256 + (nb & 3) * 64) * 64; t.ldT = 64; t.drow0 = 0; t.dcol = 0; t.nt = false; return t; }
}
__device__ __forceinline__ void tr_load(const TrItem& t, f32x4 (&v)[16], int lane) {
    const int rr = lane >> 4, cc = (lane & 15) * 4;
    const GAS float* p = (const GAS float*)t.W + (size_t)(t.k0 + rr) * t.N + t.n0 + cc;
#pragma unroll
    for (int i = 0; i < 16; ++i) v[i] = __builtin_nontemporal_load((const GAS f32x4*)(p + (size_t)(4 * i) * t.N));
}
__device__ __forceinline__ void tr_to_lds(const f32x4 (&v)[16], LAS float* scr, int lane) {
    const int rr = lane >> 4, cc = (lane & 15) * 4;
#pragma unroll
    for (int i = 0; i < 16; ++i) { LAS float* s = scr + (4 * i + rr) * 65 + cc; s[0] = v[i].x; s[1] = v[i].y; s[2] = v[i].z; s[3] = v[i].w; }
}
__device__ __forceinline__ void tr_store(const TrItem& t, const LAS float* scr, int lane) {
    const int c = lane & 7;
#pragma unroll
    for (int j = 0; j < 8; ++j) { const int n = (lane >> 3) + 8 * j; const LAS float* s = scr + (8 * c) * 65 + n;
        v4u o; o.x = pk2(s[0 * 65], s[1 * 65]); o.y = pk2(s[2 * 65], s[3 * 65]); o.z = pk2(s[4 * 65], s[5 * 65]); o.w = pk2(s[6 * 65], s[7 * 65]);
        GAS v4u* dp = (GAS v4u*)(t.WT + (size_t)(t.drow0 + n) * t.ldT + t.dcol + 8 * c);
        if (t.nt) __builtin_nontemporal_store(o, dp); else *dp = o; }
}
__device__ __forceinline__ void tr_run(const Args& args, bf16* WinT, bf16* WoutT, bf16* WguT, bf16* WdT, int base, int first, int last, int stride, LAS float* scr, int lane) {
    if (first >= last) return;
    f32x4 v[16];
    TrItem cur = tr_decode(args, WinT, WoutT, WguT, WdT, base + first); tr_load(cur, v, lane);
    for (int it = first; it < last; it += stride) {
        tr_to_lds(v, scr, lane);
        LDS_WAIT(); asm volatile("" ::: "memory");
        TrItem nx = cur; const bool more = it + stride < last;
        if (more) { nx = tr_decode(args, WinT, WoutT, WguT, WdT, base + it + stride); tr_load(nx, v, lane); }
        tr_store(cur, scr, lane);
        LDS_WAIT(); asm volatile("" ::: "memory");
        cur = nx;
    }
}

__device__ __forceinline__ void ada_task(const Args& args, int col0, int kbase, int krows, float* out, size_t opitch, LAS float* scr, int lane) {
    for (int i = 0; i < krows / 64; ++i) { const int k = kbase + 64 * i + lane;
#pragma unroll
        for (int v = 0; v < NMODV; ++v) { const float cv = (v == 0) ? args.c_ctx[k] : args.c[(v - 1) * DM + k]; scr[(64 * i + lane) * 8 + v] = cv / (1.0f + expf(-cv)); } }
    LDS_WAIT(); asm volatile("" ::: "memory");
    f32x4 acc[NMODV];
#pragma unroll
    for (int v = 0; v < NMODV; ++v) acc[v] = (f32x4){0.f, 0.f, 0.f, 0.f};
    const GAS f32x4* wp = (const GAS f32x4*)(args.w_ada + (size_t)kbase * MODW + col0) + lane;
#pragma unroll 8
    for (int kk = 0; kk < krows; ++kk) { const f32x4 w = __builtin_nontemporal_load(wp + (size_t)kk * (MODW / 4)); const f32x4 s4 = *(const LAS f32x4*)(scr + kk * 8); const float s5 = scr[kk * 8 + 4];
        acc[0] += s4.x * w; acc[1] += s4.y * w; acc[2] += s4.z * w; acc[3] += s4.w * w; acc[4] += s5 * w; }
#pragma unroll
    for (int v = 0; v < NMODV; ++v) *(GAS f32x4*)(out + (size_t)v * opitch + 4 * lane) = acc[v];
    LDS_WAIT(); asm volatile("" ::: "memory");
}
__device__ __forceinline__ int gu_row(int n, bool up) { return (n >> 7) * 256 + (n & 127) + (up ? 128 : 0); }
__device__ __forceinline__ void amax_task(const float* W, int N, int col0, int ks, float* dst, int lane) {
    const GAS f32x4* wp = (const GAS f32x4*)(W + (size_t)(ks * 256) * N + col0) + lane;
    f32x4 mx = (f32x4){0.f, 0.f, 0.f, 0.f};
#pragma unroll 8
    for (int kk = 0; kk < 256; ++kk) { const f32x4 w = wp[(size_t)kk * (N / 4)]; mx.x = fmaxf(mx.x, fabsf(w.x)); mx.y = fmaxf(mx.y, fabsf(w.y)); mx.z = fmaxf(mx.z, fabsf(w.z)); mx.w = fmaxf(mx.w, fabsf(w.w)); }
    *(GAS f32x4*)dst = mx;
}
__device__ __forceinline__ void amax_task_rot(const float* W, int N, int col0, int ks, float* dst, int lane) {
    const GAS f32x4* wp = (const GAS f32x4*)(W + (size_t)(ks * 256) * N + col0) + lane;
    f32x4 mx = (f32x4){0.f, 0.f, 0.f, 0.f};
#pragma unroll 1
    for (int kk = 0; kk < 256; kk += 8) { f32x4 w[8];
#pragma unroll
        for (int e = 0; e < 8; ++e) w[e] = wp[(size_t)(kk + e) * (N / 4)];
#pragma unroll
        for (int cc = 0; cc < 4; ++cc) { float a[8];
#pragma unroll
            for (int e = 0; e < 8; ++e) a[e] = w[e][cc];
            pg8::wht8(a);
#pragma unroll
            for (int e = 0; e < 8; ++e) mx[cc] = fmaxf(mx[cc], fabsf(a[e])); } }
    *(GAS f32x4*)dst = mx;
}
template <int NPART, bool ROT>
__device__ __forceinline__ void quant_item(const float* W, int N, int kb, int n0, const float* amaxp, int apitch, signed char* Wq, size_t ldq, float* sW, LAS float* scr, int lane) {
    const int k0 = kb * 64;
    TrItem t; t.W = W; t.N = N; t.k0 = k0; t.n0 = n0; t.WT = nullptr; t.ldT = 0; t.drow0 = 0; t.dcol = 0; t.nt = false;
    f32x4 v[16]; tr_load(t, v, lane);
    LAS float* inv = scr + 64 * 65;
    if constexpr (NPART == 0) { const float sc = sW[lane]; inv[lane] = sc > 0.f ? 1.0f / sc : 0.f; }
    else { float am = 0.f;
#pragma unroll
        for (int p = 0; p < NPART; ++p) am = fmaxf(am, amaxp[(size_t)p * apitch + lane]);
        inv[lane] = am > 0.f ? 127.0f / am : 0.f;
        if (kb == 0) sW[lane] = am * (1.0f / 127.0f); }
    tr_to_lds(v, scr, lane);
    LDS_WAIT(); asm volatile("" ::: "memory");
    const int c = lane & 7;
#pragma unroll 2
    for (int j = 0; j < 8; ++j) { const int n = (lane >> 3) + 8 * j; const LAS float* sp = scr + (8 * c) * 65 + n; const float iv = inv[n];
        float a[8];
#pragma unroll
        for (int e = 0; e < 8; ++e) a[e] = sp[e * 65];
        if (ROT) pg8::wht8(a);
        v2u o; o.x = q8x4(a[0], a[1], a[2], a[3], iv); o.y = q8x4(a[4], a[5], a[6], a[7], iv);
        *(GAS v2u*)(Wq + (size_t)n * ldq + 8 * c) = o; }
    LDS_WAIT(); asm volatile("" ::: "memory");
}
__device__ __forceinline__ void quant_row_bf16(const bf16* src, signed char* dst, float* s_out, int lane) {
    const GAS v4u* sp = (const GAS v4u*)src + lane; v4u r[8]; float am = 0.f;
#pragma unroll
    for (int j = 0; j < 8; ++j) { r[j] = sp[64 * j];
        const unsigned w4[4] = {r[j].x, r[j].y, r[j].z, r[j].w};
#pragma unroll
        for (int e = 0; e < 4; ++e) am = fmaxf(am, fmaxf(fabsf(__uint_as_float(w4[e] << 16)), fabsf(__uint_as_float(w4[e] & 0xffff0000u)))); }
#pragma unroll
    for (int o = 1; o < 64; o <<= 1) am = fmaxf(am, __shfl_xor(am, o));
    const float iv = am > 0.f ? 127.0f / am : 0.f;
    if (lane == 0) *s_out = am * (1.0f / 127.0f);
    GAS v2u* dp = (GAS v2u*)dst + lane;
#pragma unroll
    for (int j = 0; j < 8; ++j) { const unsigned w4[4] = {r[j].x, r[j].y, r[j].z, r[j].w}; unsigned o2[2];
#pragma unroll
        for (int e = 0; e < 2; ++e) o2[e] = q8x4(__uint_as_float(w4[2 * e] << 16), __uint_as_float(w4[2 * e] & 0xffff0000u), __uint_as_float(w4[2 * e + 1] << 16), __uint_as_float(w4[2 * e + 1] & 0xffff0000u), iv);
        v2u o; o.x = o2[0]; o.y = o2[1]; dp[64 * j] = o; }
}
__device__ __forceinline__ void norm_quant_row(const float* xrow, const bf16* drow, signed char* orow, float* sa_out, const LAS float* A, const LAS float* B, int lane) {
    const GAS f32x4* xr = (const GAS f32x4*)xrow + lane; const GAS v2u* dr = (const GAS v2u*)drow + lane;
    f32x4 v[16]; float s = 0.f;
#pragma unroll
    for (int j = 0; j < 16; ++j) { v[j] = add_bf4(__builtin_nontemporal_load(xr + 64 * j), dr[64 * j]); s += (v[j].x * v[j].x + v[j].y * v[j].y) + (v[j].z * v[j].z + v[j].w * v[j].w); }
    const float rstd = 1.0f / sqrtf(wave_sum(s) * (1.f / DM) + EPS);
    float am = 0.f;
#pragma unroll
    for (int j = 0; j < 16; ++j) { const f32x4 a = *(const LAS f32x4*)(A + 256 * j + 4 * lane), b = *(const LAS f32x4*)(B + 256 * j + 4 * lane);
        v[j].x = v[j].x * rstd * a.x + b.x; v[j].y = v[j].y * rstd * a.y + b.y; v[j].z = v[j].z * rstd * a.z + b.z; v[j].w = v[j].w * rstd * a.w + b.w;
        am = fmaxf(fmaxf(am, fmaxf(fabsf(v[j].x), fabsf(v[j].y))), fmaxf(fabsf(v[j].z), fabsf(v[j].w)));
        if ((j & 3) == 3) asm volatile("" ::: "memory"); }
#pragma unroll
    for (int o = 1; o < 64; o <<= 1) am = fmaxf(am, __shfl_xor(am, o));
    const float iv = am > 0.f ? 127.0f / am : 0.f;
    if (lane == 0) *sa_out = am * (1.0f / 127.0f);
    GAS unsigned* o4 = (GAS unsigned*)orow + lane;
#pragma unroll
    for (int j = 0; j < 16; ++j) o4[64 * j] = q8x4(v[j].x, v[j].y, v[j].z, v[j].w, iv);
}

constexpr int N_AMAX = 2 * 43 * 16, N_AMAXO = 16 * 16, N_AMAXD = 16 * 43;
__device__ __forceinline__ void late_slice(const Args& args, bf16* WinT, bf16* WoutT, bf16* WguT, bf16* WdT, float* MODP2, float* AMAXP, float* AMAXO, float* AMAXD, int sidx, int G, int gw, LAS float* scr, int lane) {
    const int NGW = G * 8;
    if (sidx == 0) for (int a = gw; a < 64 * KSPLIT2; a += NGW) { const int cg = a % 64, sp = a / 64;
        ada_task(args, MODC1 + cg * 256, sp * (DM / KSPLIT2), DM / KSPLIT2, MODP2 + (size_t)(sp * NMODV) * (MODW - MODC1) + cg * 256, (size_t)(MODW - MODC1), scr, lane); }
    if (sidx == 1) { for (int a_ = gw + N_AMAXD; a_ < N_AMAXD + N_AMAX + N_AMAXO; a_ += NGW) { const int a = a_ - N_AMAXD;
            if (a < N_AMAX) { const int cg = a % 86, ks = a / 86; const bool up = cg >= 43; const int col0 = (cg % 43) * 256;
                amax_task(up ? args.w_up : args.w_gate, DFF, col0, ks, AMAXP + (size_t)ks * 22016 + gu_row(col0 + 4 * lane, up), lane); }
            else { const int b2 = a - N_AMAX, cg = b2 % 16, ks = b2 / 16; amax_task(args.w_out, DM, cg * 256, ks, AMAXO + (size_t)ks * DM + cg * 256 + 4 * lane, lane); } }
        for (int a = gw; a < N_AMAXD; a += NGW) { const int cg = a % 16, ks = a / 16; amax_task_rot(args.w_down, DM, cg * 256, ks, AMAXD + (size_t)ks * DM + cg * 256 + 4 * lane, lane); } }
}

template <bool DELTA>
__device__ __forceinline__ void norm_mod_row(const float* xrow, const bf16* drow, bf16* orow, const LAS float* A, const LAS float* B, int lane) {
    const GAS f32x4* xr = (const GAS f32x4*)xrow + lane; const GAS v2u* dr = (const GAS v2u*)drow + lane;
    f32x4 v[16]; float s = 0.f;
#pragma unroll
    for (int j = 0; j < 16; ++j) { v[j] = __builtin_nontemporal_load(xr + 64 * j); if (DELTA) v[j] = add_bf4(v[j], dr[64 * j]); s += (v[j].x * v[j].x + v[j].y * v[j].y) + (v[j].z * v[j].z + v[j].w * v[j].w); }
    const float rstd = 1.0f / sqrtf(wave_sum(s) * (1.f / DM) + EPS);
    GAS v2u* o8 = (GAS v2u*)orow + lane;
#pragma unroll
    for (int j = 0; j < 16; ++j) { const f32x4 a = *(const LAS f32x4*)(A + 256 * j + 4 * lane), b = *(const LAS f32x4*)(B + 256 * j + 4 * lane);
        v2u w; w.x = pk2(v[j].x * rstd * a.x + b.x, v[j].y * rstd * a.y + b.y); w.y = pk2(v[j].z * rstd * a.z + b.z, v[j].w * rstd * a.w + b.w); o8[64 * j] = w; }
}
__device__ __forceinline__ void norm_mod_row_dual(const float* xrow, bf16* orow, signed char* qrow, float* s_out, const LAS float* A, const LAS float* B, int lane) {
    const GAS f32x4* xr = (const GAS f32x4*)xrow + lane;
    f32x4 v[16]; float s = 0.f;
#pragma unroll
    for (int j = 0; j < 16; ++j) { v[j] = __builtin_nontemporal_load(xr + 64 * j); s += (v[j].x * v[j].x + v[j].y * v[j].y) + (v[j].z * v[j].z + v[j].w * v[j].w); }
    const float rstd = 1.0f / sqrtf(wave_sum(s) * (1.f / DM) + EPS);
    GAS v2u* o8 = (GAS v2u*)orow + lane; float am = 0.f;
#pragma unroll
    for (int j = 0; j < 16; ++j) { const f32x4 a = *(const LAS f32x4*)(A + 256 * j + 4 * lane), b = *(const LAS f32x4*)(B + 256 * j + 4 * lane);
        v[j].x = v[j].x * rstd * a.x + b.x; v[j].y = v[j].y * rstd * a.y + b.y; v[j].z = v[j].z * rstd * a.z + b.z; v[j].w = v[j].w * rstd * a.w + b.w;
        v2u w; w.x = pk2(v[j].x, v[j].y); w.y = pk2(v[j].z, v[j].w); o8[64 * j] = w;
        am = fmaxf(fmaxf(am, fmaxf(fabsf(v[j].x), fabsf(v[j].y))), fmaxf(fabsf(v[j].z), fabsf(v[j].w)));
        if ((j & 3) == 3) asm volatile("" ::: "memory"); }
#pragma unroll
    for (int o = 1; o < 64; o <<= 1) am = fmaxf(am, __shfl_xor(am, o));
    const float iv = am > 0.f ? 127.0f / am : 0.f;
    if (lane == 0) *s_out = am * (1.0f / 127.0f);
    GAS unsigned* o4 = (GAS unsigned*)qrow + lane;
#pragma unroll
    for (int j = 0; j < 16; ++j) o4[64 * j] = q8x4(v[j].x, v[j].y, v[j].z, v[j].w, iv);
}

__global__ void __launch_bounds__(512, 2) mega_fwd(Args args) {
    extern __shared__ __attribute__((aligned(16))) unsigned char lds[];
    LAS unsigned char* L = (LAS unsigned char*)lds;
    volatile LAS unsigned* MISC = (volatile LAS unsigned*)(L + MISC_OFF);
    const int tid = threadIdx.x, lane = tid & 63, wave = __builtin_amdgcn_readfirstlane(tid >> 6);
    const int G = gridDim.x, bx = blockIdx.x;
    unsigned char* ws = args.ws;
    gu32* ctl = (gu32*)(ws + WS_CTL);
    float* MODP = (float*)(ws + WS_MODP); float* MOD = (float*)(ws + WS_MOD); float* MODP2 = (float*)(ws + WS_MODP2); float* AMAXP = (float*)(ws + WS_AMAXP); float* AMAXO = (float*)(ws + WS_AMAXP + 1536 * 1024); float* SWq = (float*)(ws + WS_SW); float* SWo = (float*)(ws + WS_SW + 128 * 1024);
    float* SAq = (float*)(ws + WS_SA); float* SMq = (float*)(ws + WS_SA + 128 * 1024); signed char* Wo8 = (signed char*)(ws + WS_WOUT); signed char* MIX8 = (signed char*)(ws + WS_QKV);
    float* AMAXD = (float*)(ws + WS_AMAXD); float* AMAXU = (float*)(ws + WS_AMAXD + 768 * 1024); float* AMAXQ = (float*)(ws + WS_AMAXD + 896 * 1024); float* SWqq = (float*)(ws + WS_SW + 512 * 1024); float* SWu = (float*)(ws + WS_SW + 384 * 1024); float* SHa = (float*)(ws + WS_SA + 384 * 1024);
    signed char* Wu8 = (signed char*)(ws + WS_WOUT + 16 * MiB); signed char* Wqq8 = (signed char*)(ws + WS_WOUT + 24 * MiB); signed char* Wkv8 = (signed char*)(ws + WS_MIX); float* SWkv = (float*)(ws + WS_SW + 640 * 1024); signed char* H8a = (signed char*)(ws + WS_Y + 64 * MiB); float* SWd = (float*)(ws + WS_SW + 256 * 1024); float* SActq = (float*)(ws + WS_SA + 256 * 1024);
    signed char* Wd8 = (signed char*)(ws + WS_WD); signed char* ACT8 = (signed char*)(ws + WS_WGU); unsigned* ROWMAX = (unsigned*)(ws + WS_CTL + 512 * 1024);
    signed char* Wq8 = (signed char*)(ws + WS_WGU); signed char* H8 = (signed char*)(ws + WS_H);
    bf16 *WinT = (bf16*)(ws + WS_WIN), *WoutT = (bf16*)(ws + WS_WOUT), *WguT = (bf16*)(ws + WS_WGU), *WdT = (bf16*)(ws + WS_WD);
    bf16 *CK = (bf16*)(ws + WS_CK), *CV = (bf16*)(ws + WS_CV), *DT256 = (bf16*)(ws + WS_DT256), *D2 = (bf16*)(ws + WS_D2), *DT2048 = (bf16*)(ws + WS_DT2048);
    bf16 *H = (bf16*)(ws + WS_H), *MIX = (bf16*)(ws + WS_MIX), *QKV = (bf16*)(ws + WS_QKV), *UT = (bf16*)(ws + WS_UT), *Y = (bf16*)(ws + WS_Y), *ACT = (bf16*)(ws + WS_ACT), *DL1 = (bf16*)(ws + WS_DL1), *DL2 = (bf16*)(ws + WS_DL2);
    float* OUTY = args.out; float* OUTKV = args.out + (size_t)NTOK * DM;

    for (int u = tid; u < (LDS_BYTES - LDSCTL_OFF) / 4; u += 512) ((LAS unsigned*)(L + LDSCTL_OFF))[u] = 0u;
    __syncthreads();
    XcdBarrier bar; bar.bar = (unsigned*)(ctl + CW_BAR); bar.x = 0; bar.st = nullptr;
    if (MK_N_LAUNCHES == 1) bar = xcd_barrier_post((unsigned*)(ctl + CW_BAR), MISC + 8);
    const int lo = args.ph_lo, hi = args.ph_hi;
#define IN(k) (lo <= (k) && (k) < hi)
#define SEAM(k) do { if (IN(k) && IN((k) + 1)) xcd_barrier(bar); } while (0)

    if (IN(0)) {
        const int gw = bx * 8 + wave, NGW = G * 8;
        LAS float* scr = (LAS float*)(L + wave * 16640);
        constexpr int NADA = (MODC1 / 256) * KSPLIT;
        for (int a = gw; a < NADA; a += NGW) { const int cg = a % (MODC1 / 256), sp = a / (MODC1 / 256);
            ada_task(args, cg * 256, sp * 256, 256, MODP + (size_t)(sp * NMODV) * MODW + cg * 256, (size_t)MODW, scr, lane); }
        for (int a = NGW > NADA ? (gw >= NADA ? gw - NADA : gw + NGW - NADA) : gw; a < 2 * 8 * 16; a += NGW) { const bool isq = a >= 128; const int b2 = isq ? a - 128 : a, cg = b2 % 8, ks = b2 / 8;
            amax_task(args.w_in, 8192, (isq ? 0 : 6144) + cg * 256, ks, (isq ? AMAXQ : AMAXU) + (size_t)ks * 2048 + cg * 256 + 4 * lane, lane); }
        { const int nfree = NGW - NADA;
          if (nfree >= NADA) { if (gw >= NADA) tr_run(args, WinT, WoutT, WguT, WdT, 0, gw - NADA, TR_I_IN, nfree, scr, lane); }
          else tr_run(args, WinT, WoutT, WguT, WdT, 0, gw, TR_I_IN, NGW, scr, lane); }
        const int gt = bx * 512 + tid, NGT = G * 512;
        for (int i = gt; i < 2 * 262144; i += NGT) { const bool isv = i >= 262144; const int j = isv ? i - 262144 : i;
            const GAS f32x4* src = (const GAS f32x4*)((isv ? args.cache_v : args.cache_k) + (size_t)j * 8);
            const f32x4 a = src[0], b = src[1]; v4u o; o.x = pk2(a.x, a.y); o.y = pk2(a.z, a.w); o.z = pk2(b.x, b.y); o.w = pk2(b.z, b.w);
            *(GAS v4u*)((isv ? CV : CK) + (size_t)j * 8) = o; }
        constexpr int N8_A = 2048 * 2048 / 8, N8_B = 256 * 256 / 8, N8_C = 1024 * 1024 / 8;
        for (int i = gt; i < N8_A + N8_B + N8_C; i += NGT) {
            int T, row, col8; bf16* dst; float sgn = 1.f, nrm;
            if (i < N8_A) { T = 2048; row = i / 256; col8 = (i % 256) * 8; dst = DT2048 + (size_t)row * 2048 + col8; nrm = 0.022097086912079608f; }
            else if (i < N8_A + N8_B) { const int j = i - N8_A; T = 256; row = j / 32; col8 = (j % 32) * 8; dst = DT256 + (size_t)row * 256 + col8; nrm = 0.0625f; }
            else { const int j = i - N8_A - N8_B; T = 512; row = j / 128; col8 = (j % 128) * 8; dst = D2 + (size_t)row * 1024 + col8; nrm = 0.044194173824159216f; }
            int kf, t0; bool is_sin;
            if (i < N8_A + N8_B) { const int Th = T >> 1; is_sin = row > Th; kf = is_sin ? row - Th : row; t0 = col8; }
            else { is_sin = col8 >= 512; kf = row & 511; t0 = col8 & 511; sgn = is_sin ? (row < 512 ? -1.f : 1.f) : 1.f; }
            float vals[8];
#pragma unroll
            for (int e = 0; e < 8; ++e) { const int ph = (kf * (t0 + e)) & (T - 1); const float ang = (float)ph * (2.0f / (float)T);
                vals[e] = sgn * nrm * (is_sin ? sinpif(ang) : cospif(ang)); }
            v4u o; o.x = pk2(vals[0], vals[1]); o.y = pk2(vals[2], vals[3]); o.z = pk2(vals[4], vals[5]); o.w = pk2(vals[6], vals[7]);
            *(GAS v4u*)dst = o;
        }
    }
    SEAM(0);

    if (IN(1)) {
        LAS float* A1 = (LAS float*)L; LAS float* B1 = A1 + DM;
        for (int rc = bx; rc < NTOK / 64; rc += G) {
            const int bidx = rc < 128 ? 0 : 1 + ((rc - 128) >> 5);
            __syncthreads();
#pragma unroll 1
            for (int col = tid; col < DM; col += 512) { float sh = args.b_ada[col], sc = args.b_ada[DM + col];
#pragma unroll
                for (int k = 0; k < KSPLIT; ++k) { const float* mp = MODP + ((size_t)(k * NMODV + bidx)) * MODW; sh += mp[col]; sc += mp[DM + col]; }
                A1[col] = args.norm1_g[col] * (1.0f + sc); B1[col] = sh; }
            __syncthreads();
#pragma unroll 1
            for (int i = 0; i < 8; ++i) { const int row = rc * 64 + wave * 8 + i;
                const float* xr = row < NPROMPT ? args.x_prompt + (size_t)row * DM : args.x_sample + (size_t)(row - NPROMPT) * DM;
                norm_mod_row_dual(xr, H + (size_t)row * DM, H8a + (size_t)row * DM, SHa + row, A1, B1, lane); }
        }
        __syncthreads();
        { LAS float* scr = (LAS float*)(L + wave * 16896);
          for (int it = bx * 8 + wave; it < 2 * 64 * 32; it += G * 8) { const bool isq = it >= 64 * 32; const int r = isq ? it - 64 * 32 : it, kb = r / 32, nb = r % 32;
              quant_item<16, false>(args.w_in, 8192, kb, (isq ? 0 : 6144) + nb * 64, (isq ? AMAXQ : AMAXU) + nb * 64, 2048, (isq ? Wqq8 : Wu8) + (size_t)(nb * 64) * DM + kb * 64, (size_t)DM, (isq ? SWqq : SWu) + nb * 64, scr, lane); } }
        for (int n = bx * 8 + wave; n < 2 * DATT; n += G * 8) quant_row_bf16(WinT + (size_t)(DATT + n) * DM, Wkv8 + (size_t)n * DM, SWkv + n, lane);
    }
    SEAM(1);

    if (IN(2)) {
        const int gw2 = bx * 8 + wave; LAS float* scr2 = (LAS float*)(L + wave * 16640);
        { const pg8::Gemm g = pg8::gemm_rowmajor(DM, DM, DM); pg8::QkvSched S; S.init(G, bx, H, WinT, 0, 2);
          pg8::EpiQKV E{QKV, OUTKV};
          pg8::gemm_phase<pg8::EpiQKV, pg8::QkvSched, true>(L, g, S, E); }
        __syncthreads(); late_slice(args, WinT, WoutT, WguT, WdT, MODP2, AMAXP, AMAXO, AMAXD, 0, G, gw2, scr2, lane); __syncthreads();
        if (G == 256) { const pg8::Gemm g = pg8::gemm_rowmajor(DM / 2, DM / 2, DM / 2); pg8::TileSched S;
          S.init(32, 16, 1, G, bx, H8a + (size_t)32 * 256 * DM, Wkv8, (size_t)256 * DM, (size_t)256 * DM, 0, 0); S.pm0 = 32; S.pn0 = 8;
          pg8::EpiKV8 E{QKV, SHa, SWkv};
          pg8::gemm_phase<pg8::EpiKV8, pg8::TileSched, true, true>(L, g, S, E); }
        else { const pg8::Gemm g = pg8::gemm_rowmajor(DM, DM, DM); pg8::QkvSched S; S.init(G, bx, H, WinT, 2, 1 << 20);
          pg8::EpiQKV E{QKV, OUTKV};
          pg8::gemm_phase<pg8::EpiQKV, pg8::QkvSched, true>(L, g, S, E); }
        __syncthreads(); late_slice(args, WinT, WoutT, WguT, WdT, MODP2, AMAXP, AMAXO, AMAXD, 1, G, gw2, scr2, lane); __syncthreads();
        { const pg8::Gemm g = pg8::gemm_rowmajor(DM / 2, DM / 2, DM / 2); pg8::TileSched S; S.init(64, 8, 1, G, bx, H8a, Wqq8, (size_t)256 * DM, (size_t)256 * DM, 0, 0);
          pg8::EpiQ8 E{QKV, SHa, SWqq};
          pg8::gemm_phase<pg8::EpiQ8, pg8::TileSched, true, true>(L, g, S, E); }
        { const pg8::Gemm g = pg8::gemm_rowmajor(DM / 2, DM / 2, DM / 2); pg8::TileSched S; S.init(8, 64, 1, G, bx, Wu8, H8a, (size_t)256 * DM, (size_t)256 * DM, 0, 0);
          pg8::EpiUT8 E{UT, SWu, SHa};
          pg8::gemm_phase<pg8::EpiUT8, pg8::TileSched, true, true>(L, g, S, E); }
    }
    SEAM(2);

    if (IN(3)) {
        const bf16* Qb = QKV; const bf16* Kb = QKV + (size_t)NTOK * DATT; const bf16* Vb = QKV + (size_t)2 * NTOK * DATT;
        for (int u = bx; u < 512; u += G) {
            const int b = u >> 4, h = u & 15; const size_t ro = (size_t)(b * 256) * DATT + h * HD;
            att::AttnUnit U{Qb + ro, Kb + ro, Vb + ro, Kb + ro, Vb + ro, MIX + (size_t)(b * 256) * DM + h * HD, nullptr, 4, 0, 0, 0};
            att::attn_unit<false>(U, (char*)lds);
        }
        for (int u = bx; u < 512; u += G) {
            const int rb = u & 7, h = (u >> 3) & 15, b = u >> 7, r0 = rb * 4;
            const int kr0 = rb == 0 ? 0 : (rb == 7 ? 24 : r0 - 4), n0 = (rb == 0 || rb == 7) ? 8 : 12;
            const size_t tok0 = NPROMPT + (size_t)b * 2048; const size_t co = (size_t)(b * 256) * DATT + h * HD;
            att::AttnUnit U{Qb + (tok0 + r0 * 64) * DATT + h * HD, Kb + (tok0 + kr0 * 64) * DATT + h * HD, Vb + (tok0 + kr0 * 64) * DATT + h * HD,
                            CK + co, CV + co, MIX + (tok0 + r0 * 64) * DM + h * HD, args.rpb + h * 15 * 31, n0, 4, r0, kr0};
            att::attn_unit<true>(U, (char*)lds);
        }
        __syncthreads();
        { const pg8::Gemm g = pg8::gemm_rowmajor(256, NTOK, 256); pg8::TileSched S; S.init(1, 8, 32, G, bx, DT256, UT, (size_t)256 * 256 * 2, (size_t)256 * NTOK * 2, 0, (size_t)256 * 2);
          pg8::EpiY2 E{Y, 128, 0};
          pg8::gemm_phase<pg8::EpiY2, pg8::TileSched, true>(L, g, S, E); }
        { const pg8::Gemm g = pg8::gemm_rowmajor(2048, NTOK, 2048); pg8::TileSched S; S.init(8, 8, 4, G, bx, DT2048, UT + NPROMPT, (size_t)256 * 2048 * 2, (size_t)256 * NTOK * 2, 0, (size_t)2048 * 2);
          pg8::EpiY2 E{Y, 1024, 4096};
          pg8::gemm_phase<pg8::EpiY2, pg8::TileSched, true>(L, g, S, E); }
    }
    SEAM(3);

    if (IN(4)) {
        for (int idx = bx * 512 + tid; idx < NMODV * MODW; idx += G * 512) { const int v = idx / MODW, j = idx % MODW; float sm = args.b_ada[j];
            if (j < MODC1) {
#pragma unroll
                for (int k = 0; k < KSPLIT; ++k) sm += MODP[((size_t)(k * NMODV + v)) * MODW + j]; }
            else {
#pragma unroll 8
                for (int k = 0; k < KSPLIT2; ++k) sm += MODP2[((size_t)(k * NMODV + v)) * (MODW - MODC1) + (j - MODC1)]; }
            MOD[idx] = sm; }
        { LAS float* scr = (LAS float*)(L + wave * 16896);
          for (int it = bx * 8 + wave; it < TR_I_OUT; it += G * 8) { const int kb = it / 64, nb = it % 64; quant_item<16, false>(args.w_out, DM, kb, nb * 64, AMAXO + nb * 64, DM, Wo8 + (size_t)(nb * 64) * DM + kb * 64, (size_t)DM, SWo + nb * 64, scr, lane); } }
        __syncthreads();
        for (int t = bx * 8 + wave; t < 36 * 4 * 2 * 8; t += G * 8) {
            const int chunk = t & 7, which = (t >> 3) & 1, g = (t >> 4) & 3, bb = t >> 6;
            int R, T, tok0; if (bb < 32) { R = bb * 128; T = 256; tok0 = bb * 256; } else { R = 4096 + (bb - 32) * 1024; T = 2048; tok0 = NPROMPT + (bb - 32) * 2048; }
            const GAS v4u* yp = (const GAS v4u*)(Y + (size_t)R * DM + g * 1024 + which * 512);
            const int kc = chunk * 64 + lane; const GAS v4u* dp = (const GAS v4u*)(D2 + (size_t)kc * 1024);
            float a0 = 0.f, a1 = 0.f;
#pragma unroll 16
            for (int c8 = 0; c8 < 64; ++c8) { const v4u y = yp[c8], d = dp[c8];
                a0 += __uint_as_float(y.x << 16) * __uint_as_float(d.x << 16); a1 += __uint_as_float(y.x & 0xffff0000u) * __uint_as_float(d.x & 0xffff0000u);
                a0 += __uint_as_float(y.y << 16) * __uint_as_float(d.y << 16); a1 += __uint_as_float(y.y & 0xffff0000u) * __uint_as_float(d.y & 0xffff0000u);
                a0 += __uint_as_float(y.z << 16) * __uint_as_float(d.z << 16); a1 += __uint_as_float(y.z & 0xffff0000u) * __uint_as_float(d.z & 0xffff0000u);
                a0 += __uint_as_float(y.w << 16) * __uint_as_float(d.w << 16); a1 += __uint_as_float(y.w & 0xffff0000u) * __uint_as_float(d.w & 0xffff0000u); }
            MIX[(size_t)(tok0 + (which ? (T >> 1) : 0)) * DM + DATT + g * 512 + kc] = (bf16)f2bf(a0 + a1);
        }
        const pg8::Gemm g = pg8::gemm_rowmajor(DM, 1024, 1024); pg8::TileSched S; S.init(32, 4, 4, G, bx, Y, D2, (size_t)256 * DM * 2, (size_t)256 * 1024 * 2, (size_t)1024 * 2, 0);
        pg8::EpiF2x E{MIX};
        pg8::gemm_phase<pg8::EpiF2x, pg8::TileSched, true>(L, g, S, E);
    }
    SEAM(4);

    if (IN(5)) {
        for (int row = bx * 8 + wave; row < NTOK; row += G * 8) quant_row_bf16(MIX + (size_t)row * DM, MIX8 + (size_t)row * DM, SMq + row, lane);
        for (int n = bx * 512 + tid; n < DM; n += G * 512) { float am = 0.f;
#pragma unroll
            for (int p = 0; p < 43; ++p) am = fmaxf(am, AMAXD[(size_t)p * DM + n]);
            SWd[n] = am * (1.0f / 127.0f); }
    }
    SEAM(5);

    if (IN(6)) {
        const pg8::Gemm g = pg8::gemm_rowmajor(DM / 2, DM / 2, DM / 2); pg8::TileSched S; S.init(64, 16, 1, G, bx, MIX8, Wo8, (size_t)256 * DM, (size_t)256 * DM, 0, 0);
        pg8::EpiDelta8 E{DL1, MOD + 2 * DM, SMq, SWo};
        pg8::gemm_phase<pg8::EpiDelta8, pg8::TileSched, true, true>(L, g, S, E);
    }
    SEAM(6);

    if (IN(7)) {
        LAS float* A1 = (LAS float*)L; LAS float* B1 = A1 + DM;
        for (int rc = bx; rc < NTOK / 64; rc += G) {
            const int bidx = rc < 128 ? 0 : 1 + ((rc - 128) >> 5);
            __syncthreads();
#pragma unroll 2
            for (int col = tid; col < DM; col += 512) { const float* mp = MOD + (size_t)bidx * MODW; A1[col] = args.norm2_g[col] * (1.0f + mp[4 * DM + col]); B1[col] = mp[3 * DM + col]; }
            __syncthreads();
#pragma unroll 1
            for (int i = 0; i < 8; ++i) { const int row = rc * 64 + wave * 8 + i;
                const float* xr = row < NPROMPT ? args.x_prompt + (size_t)row * DM : args.x_sample + (size_t)(row - NPROMPT) * DM;
                norm_quant_row(xr, DL1 + (size_t)row * DM, H8 + (size_t)row * DM, SAq + row, A1, B1, lane); }
        }
        __syncthreads();
        { LAS float* scr = (LAS float*)(L + wave * 16896);
          for (int it = bx * 8 + wave; it < 2 * TR_I_G; it += G * 8) { const bool up = it >= TR_I_G; const int r = up ? it - TR_I_G : it; const int kb = r / 172, n0 = (r % 172) * 64, r0 = gu_row(n0, up); quant_item<16, false>(up ? args.w_up : args.w_gate, DFF, kb, n0, AMAXP + r0, 22016, Wq8 + (size_t)r0 * DM + kb * 64, (size_t)DM, SWq + r0, scr, lane); } }
        { LAS float* scr = (LAS float*)(L + wave * 16896);
          for (int it = bx * 8 + wave; it < TR_I_D; it += G * 8) { const int kb = it / 64, nb = it % 64;
              quant_item<0, true>(args.w_down, DM, kb, nb * 64, nullptr, 0, Wd8 + ((size_t)((nb >> 2) * (DFF / 128) + (kb >> 1)) * 256 + (nb & 3) * 64) * 128 + (kb & 1) * 64, (size_t)128, SWd + nb * 64, scr, lane); } }
    }
    SEAM(7);

    if (IN(8)) {
        const pg8::Gemm g = pg8::gemm_rowmajor(DM / 2, DM / 2, DM / 2); pg8::TileSched S; S.init(64, 86, 1, G, bx, H8, Wq8, (size_t)256 * DM, (size_t)256 * DM, 0, 0);
        pg8::EpiSwiglu8 E{ACT, SAq, SWq, ROWMAX};
        pg8::gemm_phase<pg8::EpiSwiglu8, pg8::TileSched, true, true>(L, g, S, E);
    }
    SEAM(8);

    if (IN(9)) {
        for (int it = bx * 8 + wave; it < 64 * (DFF / 128); it += G * 8) { const int kt8 = (DFF / 128) - 1 - it / 64, pm = it % 64;
            const bf16* src = ACT + (size_t)(pm * (DFF / 64) + 2 * kt8) * 256 * 64; signed char* dst = ACT8 + (size_t)(pm * (DFF / 128) + kt8) * 256 * 128; const int c = lane & 7;
            const bf16* srcl = src + (size_t)(c >> 2) * 256 * 64 + (c & 3) * 16;
            if (kt8 == 0 && c == 0) { for (int j = 0; j < 32; ++j) { const int row = (lane >> 3) + 8 * j; SActq[pm * 256 + row] = __uint_as_float(ROWMAX[pm * 256 + row]) * (1.0f / 127.0f); } }
#pragma unroll 1
            for (int j0 = 0; j0 < 32; j0 += 8) {
                v4u r0[8], r1[8]; float rm[8];
#pragma unroll
                for (int jj = 0; jj < 8; ++jj) { const int row = (lane >> 3) + 8 * (j0 + jj); rm[jj] = __uint_as_float(ROWMAX[pm * 256 + row]);
                    r0[jj] = __builtin_nontemporal_load((const GAS v4u*)(srcl + row * 64)); r1[jj] = __builtin_nontemporal_load((const GAS v4u*)(srcl + row * 64 + 8)); }
#pragma unroll
                for (int jj = 0; jj < 8; ++jj) { const int row = (lane >> 3) + 8 * (j0 + jj); const float iv = rm[jj] > 0.f ? 127.0f * __builtin_amdgcn_rcpf(rm[jj]) : 0.f;
                    const unsigned w8[8] = {r0[jj].x, r0[jj].y, r0[jj].z, r0[jj].w, r1[jj].x, r1[jj].y, r1[jj].z, r1[jj].w}; unsigned o4[4];
#pragma unroll
                    for (int e = 0; e < 4; ++e) o4[e] = q8x4(__uint_as_float(w8[2 * e] << 16), __uint_as_float(w8[2 * e] & 0xffff0000u), __uint_as_float(w8[2 * e + 1] << 16), __uint_as_float(w8[2 * e + 1] & 0xffff0000u), iv);
                    v4u o; o.x = o4[0]; o.y = o4[1]; o.z = o4[2]; o.w = o4[3]; *(GAS v4u*)(dst + (size_t)row * 128 + c * 16) = o; }
            }
        }
    }
    SEAM(9);

    if (IN(10)) {
        const pg8::Gemm g{64, 64, DFF / 2, (size_t)32768, (size_t)32768, (size_t)16384, (size_t)16384};
        pg8::TileSched S; S.init(64, 16, 1, G, bx, ACT8, Wd8, (size_t)256 * DFF, (size_t)256 * DFF, 0, 0);
        S.wgm = 2;
        pg8::EpiDelta8 E{DL2, MOD + 5 * DM, SActq, SWd};
        pg8::gemm_phase<pg8::EpiDelta8, pg8::TileSched, true, true>(L, g, S, E);
    }
    SEAM(10);

    if (IN(11)) {
        for (int row = bx * 8 + wave; row < NTOK; row += G * 8) {
            const float* xrow = row < NPROMPT ? args.x_prompt + (size_t)row * DM : args.x_sample + (size_t)(row - NPROMPT) * DM;
            const GAS f32x4* xr = (const GAS f32x4*)xrow + lane; const GAS f32x4* gr = (const GAS f32x4*)args.final_g + lane;
            const GAS v2u* d1 = (const GAS v2u*)(DL1 + (size_t)row * DM) + lane; const GAS v2u* d2 = (const GAS v2u*)(DL2 + (size_t)row * DM) + lane;
            GAS f32x4* yr = (GAS f32x4*)(OUTY + (size_t)row * DM) + lane;
            f32x4 v[16]; float s = 0.f;
#pragma unroll
            for (int j = 0; j < 16; ++j) { v[j] = add_bf4(add_bf4(__builtin_nontemporal_load(xr + 64 * j), __builtin_nontemporal_load(d1 + 64 * j)), __builtin_nontemporal_load(d2 + 64 * j)); s += (v[j].x * v[j].x + v[j].y * v[j].y) + (v[j].z * v[j].z + v[j].w * v[j].w); }
            const float rstd = 1.0f / sqrtf(wave_sum(s) * (1.f / DM) + EPS);
#pragma unroll
            for (int j = 0; j < 16; ++j) __builtin_nontemporal_store(v[j] * rstd * gr[64 * j], yr + 64 * j);
        }
    }
#undef IN
#undef SEAM
}

extern "C" void kernel_launch(void* const* d_in, const int* in_sizes, int n_in, void* d_out, int out_size, void* d_ws, size_t ws_size, hipStream_t stream) {
    static int grid = 0;
    if (grid == 0) {
        if (n_in != 17 || ws_size < WS_END) { fprintf(stderr, "kernel_launch: need 17 inputs and >= %zu bytes of workspace; got %d, %zu\n", (size_t)WS_END, n_in, ws_size); grid = -1; return; }
        int dev = 0, cus = 0, per_cu = 0;
        if (hipGetDevice(&dev) != hipSuccess || hipDeviceGetAttribute(&cus, hipDeviceAttributeMultiprocessorCount, dev) != hipSuccess) { grid = -1; return; }
        if (hipFuncSetAttribute((const void*)mega_fwd, hipFuncAttributeMaxDynamicSharedMemorySize, LDS_BYTES) != hipSuccess) { fprintf(stderr, "kernel_launch: hipFuncSetAttribute failed\n"); grid = -1; return; }
        if (hipOccupancyMaxActiveBlocksPerMultiprocessor(&per_cu, (const void*)mega_fwd, 512, LDS_BYTES) != hipSuccess || per_cu < 1)
            fprintf(stderr, "kernel_launch: note: occupancy query reports %d workgroups per CU\n", per_cu);
        (void)hipGetLastError();
        grid = cus;
    }
    if (grid < 0) return;
    if (hipMemsetAsync((char*)d_ws + WS_CTL, 0, CTL_ZERO_BYTES, stream) != hipSuccess) return;
    Args a{};
    a.x_prompt = (const float*)d_in[0]; a.x_sample = (const float*)d_in[1]; a.cache_k = (const float*)d_in[2]; a.cache_v = (const float*)d_in[3];
    a.c = (const float*)d_in[4]; a.c_ctx = (const float*)d_in[5]; a.w_ada = (const float*)d_in[6]; a.b_ada = (const float*)d_in[7]; a.norm1_g = (const float*)d_in[8];
    a.w_in = (const float*)d_in[9]; a.rpb = (const float*)d_in[10]; a.w_out = (const float*)d_in[11]; a.norm2_g = (const float*)d_in[12];
    a.w_gate = (const float*)d_in[13]; a.w_up = (const float*)d_in[14]; a.w_down = (const float*)d_in[15]; a.final_g = (const float*)d_in[16];
    a.out = (float*)d_out; a.ws = (unsigned char*)d_ws;
    constexpr int NPH = 12;
    if (MK_N_LAUNCHES == 1) {
        a.ph_lo = 0; a.ph_hi = NPH;
        hipLaunchKernelGGL(mega_fwd, dim3(grid), dim3(512), LDS_BYTES, stream, a);
    } else {
        for (int p = 0; p < NPH; ++p) { a.ph_lo = p; a.ph_hi = p + 1; hipLaunchKernelGGL(mega_fwd, dim3(grid), dim3(512), LDS_BYTES, stream, a);
        }
    }
    const hipError_t le = hipPeekAtLastError();
    if (le != hipSuccess) fprintf(stderr, "kernel_launch: launch failed: %s\n", hipGetErrorName(le));
}
```

```cpp
#include <hip/hip_runtime.h>
#include <hip/hip_bf16.h>
#include <cstdio>
#include <cstdint>

#ifndef MK_N_LAUNCHES
#define MK_N_LAUNCHES 1
#endif

constexpr int DM = 4096, NTOK = 16384, NPROMPT = 8192, DATT = 2048, DFF = 11008, NH = 16, HD = 128;
constexpr int NMODV = 5, MODW = 6 * DM;
constexpr int KSPLIT = 16, KSPLIT2 = 32, MODC1 = 8192;
constexpr float EPS = 1e-6f;

constexpr size_t MiB = 1u << 20;
constexpr size_t WS_CTL = 0, CTL_ZERO_BYTES = 1 * MiB;
constexpr size_t WS_MODP = 1 * MiB;
constexpr size_t WS_MOD = 9 * MiB;
constexpr size_t WS_WIN = 10 * MiB;
constexpr size_t WS_WOUT = WS_WIN + 64 * MiB;
constexpr size_t WS_WGU = WS_WOUT + 32 * MiB;
constexpr size_t WS_WD = WS_WGU + 172 * MiB;
constexpr size_t WS_CK = WS_WD + 86 * MiB;
constexpr size_t WS_CV = WS_CK + 4 * MiB;
constexpr size_t WS_DT256 = WS_CV + 4 * MiB;
constexpr size_t WS_D2 = WS_DT256 + 1 * MiB;
constexpr size_t WS_DT2048 = WS_D2 + 2 * MiB;
constexpr size_t WS_H = WS_DT2048 + 16 * MiB;
constexpr size_t WS_MIX = WS_H + 128 * MiB;
constexpr size_t WS_QKV = WS_MIX + 128 * MiB;
constexpr size_t WS_UT = WS_QKV + 192 * MiB;
constexpr size_t WS_Y = WS_UT + 64 * MiB;
constexpr size_t WS_ACT = WS_QKV;
constexpr size_t WS_DL1 = WS_Y + 128 * MiB;
constexpr size_t WS_DL2 = WS_H;
constexpr size_t WS_MODP2 = WS_DL1 + 128 * MiB;
constexpr size_t WS_AMAXP = WS_MODP2 + 11 * MiB;
constexpr size_t WS_SW = WS_AMAXP + 2 * MiB;
constexpr size_t WS_SA = WS_SW + 1 * MiB;
constexpr size_t WS_AMAXD = WS_SA + 1 * MiB;
constexpr size_t WS_END = WS_AMAXD + 1 * MiB;
static_assert(WS_ACT + (size_t)NTOK * DFF * 2 <= WS_END, "ACT overlay");

constexpr int CW_BAR = 4096;

constexpr int RING_BYTES = 131072;
constexpr int LDSCTL_OFF = 146944, MISC_OFF = LDSCTL_OFF + 320;
constexpr int LDS_BYTES = 147456;

#define GAS __attribute__((address_space(1)))
#define LAS __attribute__((address_space(3)))
typedef unsigned short bf16;
typedef unsigned v4u __attribute__((ext_vector_type(4)));
typedef unsigned v2u __attribute__((ext_vector_type(2)));
typedef GAS unsigned gu32;
#define RLX_AGENT __ATOMIC_RELAXED, __HIP_MEMORY_SCOPE_AGENT
#define LDS_WAIT() asm volatile("s_waitcnt lgkmcnt(0)" ::: "memory")
#define VM_WAIT() asm volatile("s_waitcnt vmcnt(0)" ::: "memory")

namespace pg8 {
#define PG8_LAS __attribute__((address_space(3)))
typedef unsigned short bf16_t;
typedef short bf16x8 __attribute__((ext_vector_type(8)));
typedef float f32x4 __attribute__((ext_vector_type(4)));
typedef float f32x2 __attribute__((ext_vector_type(2)));
typedef unsigned u32x4 __attribute__((ext_vector_type(4)));
constexpr int BM = 256, BK = 64, HALF = 128, HTB = HALF * BK * 2, STAGE_BYTES = 8 * HTB, NXCD = 8, WGM = 8;

__host__ __device__ __forceinline__ int lds_byte(int r, int c) { const int st = (r >> 4) * 2 + (c >> 5), rr = r & 15, cc = c & 31, ob = rr * 64 + cc * 2; return st * 1024 + (ob ^ (((ob >> 9) & 1) << 5)); }
__host__ __device__ __forceinline__ void stage_rc(int b, int& R, int& C) { const int st = b / 1024, sb = b % 1024, swz = sb ^ (((sb >> 9) & 1) << 5); R = (st >> 1) * 16 + swz / 64; C = (st & 1) * 32 + (swz % 64) / 2; }
__host__ __device__ __forceinline__ int perm32(int rho) { const int n = rho >> 4, i = rho & 15; return 8 * (i >> 2) + 4 * n + (i & 3); }

struct Unit { const char* a; const char* b; int pm, pn, z; };
struct Gemm { int lda, ldb, K; size_t kstepA, kstepB, hstepA, hstepB; };
__device__ __forceinline__ Gemm gemm_rowmajor(int lda, int ldb, int K) { return Gemm{lda, ldb, K, (size_t)(BK * 2), (size_t)(BK * 2), (size_t)HALF * lda * 2, (size_t)HALF * ldb * 2}; }

struct TileSched {
    int nM, nN, per, nwg, G, c, wgm = WGM, pm0 = 0, pn0 = 0; const char* A; const char* B; size_t a_tile, b_tile, a_z, b_z;
    __device__ void init(int nM_, int nN_, int nZ_, int G_, int c_, const void* A_, const void* B_, size_t a_tile_, size_t b_tile_, size_t a_z_, size_t b_z_) {
        nM = nM_; nN = nN_; per = nM_ * nN_; nwg = per * nZ_; G = G_; c = c_; A = (const char*)A_; B = (const char*)B_; a_tile = a_tile_; b_tile = b_tile_; a_z = a_z_; b_z = b_z_; }
    __device__ bool next(int i, Unit& u) const {
        const long L = (long)i * G + c; if (L >= nwg) return false;
        int wgid = (int)L; { const int q = nwg / NXCD, r = nwg % NXCD, xcd = wgid % NXCD, off = wgid / NXCD; wgid = (xcd < r ? xcd * (q + 1) : r * (q + 1) + (xcd - r) * q) + off; }
        const int z = wgid / per, w = wgid % per;
        const int nig = wgm * nN, gid = w / nig, fm = gid * wgm, gsz = (nM - fm) < wgm ? (nM - fm) : wgm;
        u.pm = fm + ((w % nig) % gsz); u.pn = (w % nig) / gsz; u.z = z;
        u.a = A + (size_t)z * a_z + (size_t)u.pm * a_tile; u.b = B + (size_t)z * b_z + (size_t)u.pn * b_tile; u.pm += pm0; u.pn += pn0; return true;
    }
};
struct QkvSched {
    TileSched kvp, smp, plain; bool split; int i0, i1;
    __device__ void init(int G, int c, const bf16_t* Hm, const bf16_t* W, int i0_, int i1_) {
        const size_t tb = (size_t)256 * DM * 2; split = (G == 256); i0 = i0_; i1 = i1_;
        plain.init(64, 16, 1, G, c, Hm, W + (size_t)8 * 256 * DM, tb, tb, 0, 0); plain.pn0 = 8;
        kvp.init(32, 16, 1, G, c, Hm, W + (size_t)8 * 256 * DM, tb, tb, 0, 0); kvp.pn0 = 8;
        smp.init(32, 16, 1, G, c, Hm + (size_t)32 * 256 * DM, W + (size_t)8 * 256 * DM, tb, tb, 0, 0); smp.pm0 = 32; smp.pn0 = 8;
    }
    __device__ bool next(int i_, Unit& u) const {
        const int i = i_ + i0; if (i >= i1) return false;
        if (!split) return plain.next(i, u);
        if (i < 2) return kvp.next(i, u);
        return smp.next(i - 2, u);
    }
};

__device__ __forceinline__ unsigned cvt_pk_bf16(float lo, float hi) { unsigned r; asm volatile("v_cvt_pk_bf16_f32 %0, %1, %2" : "=v"(r) : "v"(lo), "v"(hi)); return r; }

__device__ __forceinline__ void store_tile_bf16(const f32x4 (&acc)[2][2][4][2], bf16_t* base, size_t ldc, int wr, int wc, int fr, int fq) {
    bf16_t* p0 = base + (size_t)(wr * 64 + fr) * ldc + wc * 32 + 8 * fq;
#pragma unroll
    for (int ai = 0; ai < 2; ++ai)
#pragma unroll
        for (int m = 0; m < 4; ++m) { bf16_t* rowp = p0 + (size_t)(ai * HALF + m * 16) * ldc;
#pragma unroll
            for (int bj = 0; bj < 2; ++bj) { const f32x4 v0 = acc[ai][bj][m][0], v1 = acc[ai][bj][m][1];
                u32x4 w; w.x = cvt_pk_bf16(v0[0], v0[1]); w.y = cvt_pk_bf16(v0[2], v0[3]); w.z = cvt_pk_bf16(v1[0], v1[1]); w.w = cvt_pk_bf16(v1[2], v1[3]);
                *(u32x4*)(rowp + bj * HALF) = w; } }
}

struct EpiQKV {
    static constexpr bool PERM = true;
    bf16_t* QKV; float* outkv;
    __device__ __forceinline__ void operator()(const f32x4 (&acc)[2][2][4][2], const Unit& u, int wr, int wc, int fr, int fq) const {
        const int t = u.pn >> 3, colt = (u.pn & 7) * 256;
        bf16_t* base = QKV + (size_t)t * NTOK * DATT + (size_t)(u.pm * 256) * DATT + colt;
        store_tile_bf16(acc, base, DATT, wr, wc, fr, fq);
        if (u.pm < 32 && t >= 1) {
            float* p0 = outkv + (size_t)(t - 1) * NPROMPT * DATT + (size_t)(u.pm * 256 + wr * 64 + fr) * DATT + colt + wc * 32 + 8 * fq;
#pragma unroll
            for (int ai = 0; ai < 2; ++ai)
#pragma unroll
                for (int m = 0; m < 4; ++m) { float* rowp = p0 + (size_t)(ai * HALF + m * 16) * DATT;
#pragma unroll
                    for (int bj = 0; bj < 2; ++bj) { __builtin_nontemporal_store(acc[ai][bj][m][0], (f32x4*)(rowp + bj * HALF)); __builtin_nontemporal_store(acc[ai][bj][m][1], (f32x4*)(rowp + bj * HALF + 4)); } }
        }
    }
};
struct EpiUT {
    static constexpr bool PERM = true; bf16_t* UT;
    __device__ __forceinline__ void operator()(const f32x4 (&acc)[2][2][4][2], const Unit& u, int wr, int wc, int fr, int fq) const {
        store_tile_bf16(acc, UT + (size_t)(u.pm * 256) * NTOK + u.pn * 256, NTOK, wr, wc, fr, fq); }
};
__device__ __forceinline__ void store_half_bf16(const f32x4 (&a)[2][4][2], bf16_t* base, long rstride, int skip_r, int wr, int wc, int fr, int fq) {
#pragma unroll
    for (int m = 0; m < 4; ++m) { const int r = wr * 64 + m * 16 + fr; bf16_t* rowp = base + (long)r * rstride + wc * 32 + 8 * fq;
        if (r != skip_r) {
#pragma unroll
            for (int bj = 0; bj < 2; ++bj) { const f32x4 v0 = a[bj][m][0], v1 = a[bj][m][1];
                u32x4 w; w.x = cvt_pk_bf16(v0[0], v0[1]); w.y = cvt_pk_bf16(v0[2], v0[3]); w.z = cvt_pk_bf16(v1[0], v1[1]); w.w = cvt_pk_bf16(v1[2], v1[3]);
                *(u32x4*)(rowp + bj * HALF) = w; } } }
}
struct EpiY2 {
    static constexpr bool PERM = true; bf16_t* Y2; int Th, row_base;
    __device__ __forceinline__ void operator()(const f32x4 (&acc)[2][2][4][2], const Unit& u, int wr, int wc, int fr, int fq) const {
        const int g = u.pn >> 1, c0 = (u.pn & 1) * 256;
#pragma unroll
        for (int ai = 0; ai < 2; ++ai) { const int m0 = u.pm * 256 + ai * HALF, cs = m0 / Th, kt0 = m0 % Th;
            store_half_bf16(acc[ai], Y2 + (size_t)(row_base + u.z * Th + kt0) * DM + g * 1024 + cs * 512 + c0, DM, -1, wr, wc, fr, fq); }
    }
};
struct EpiF2x {
    static constexpr bool PERM = true; bf16_t* MIX;
    __device__ __forceinline__ void operator()(const f32x4 (&acc)[2][2][4][2], const Unit& u, int wr, int wc, int fr, int fq) const {
        const int mir = u.pn >> 1, c0 = (u.pn & 1) * 256;
#pragma unroll
        for (int ai = 0; ai < 2; ++ai) { const int R0 = u.pm * 256 + ai * HALF; int T, tok0, kt0;
            if (R0 < 4096) { T = 256; tok0 = (R0 >> 7) * 256; kt0 = 0; } else { const int Rp = R0 - 4096; T = 2048; tok0 = NPROMPT + (Rp >> 10) * 2048; kt0 = Rp & 1023; }
            const int tok = tok0 + (mir ? T - kt0 : kt0);
            store_half_bf16(acc[ai], MIX + (size_t)tok * DM + DATT + u.z * 512 + c0, mir ? -(long)DM : (long)DM, kt0 == 0 ? 0 : -1, wr, wc, fr, fq); }
    }
};
struct EpiDelta {
    static constexpr bool PERM = true;
    bf16_t* Dl; const float* gate;
    __device__ __forceinline__ void operator()(const f32x4 (&acc)[2][2][4][2], const Unit& u, int wr, int wc, int fr, int fq) const {
        const int bidx = u.pm < 32 ? 0 : 1 + ((u.pm - 32) >> 3);
        const int col0 = u.pn * 256 + wc * 32 + 8 * fq;
        const float* gp = gate + (size_t)bidx * MODW + col0;
        f32x4 gv[2][2];
#pragma unroll
        for (int bj = 0; bj < 2; ++bj)
#pragma unroll
            for (int n = 0; n < 2; ++n) gv[bj][n] = *(const f32x4*)(gp + bj * HALF + 4 * n);
        bf16_t* p0 = Dl + (size_t)(u.pm * 256 + wr * 64 + fr) * DM + col0;
#pragma unroll
        for (int ai = 0; ai < 2; ++ai)
#pragma unroll
            for (int m = 0; m < 4; ++m) { bf16_t* rowp = p0 + (size_t)(ai * HALF + m * 16) * DM;
#pragma unroll
                for (int bj = 0; bj < 2; ++bj) { const f32x4 v0 = acc[ai][bj][m][0] * gv[bj][0], v1 = acc[ai][bj][m][1] * gv[bj][1];
                    u32x4 w; w.x = cvt_pk_bf16(v0[0], v0[1]); w.y = cvt_pk_bf16(v0[2], v0[3]); w.z = cvt_pk_bf16(v1[0], v1[1]); w.w = cvt_pk_bf16(v1[2], v1[3]);
                    *(u32x4*)(rowp + bj * HALF) = w; } }
    }
};
struct EpiSwiglu {
    static constexpr bool PERM = true; bf16_t* ACT;
    static __device__ __forceinline__ float sw(float g, float u) { return g * __builtin_amdgcn_rcpf(1.0f + __builtin_amdgcn_exp2f(-1.4426950408889634f * g)) * u; }
    __device__ __forceinline__ void operator()(const f32x4 (&acc)[2][2][4][2], const Unit& u, int wr, int wc, int fr, int fq) const {
        bf16_t* p0 = ACT + ((size_t)(u.pm * (DFF / 64) + u.pn * 2 + (wc >> 1)) * 256 + wr * 64 + fr) * 64 + (wc & 1) * 32 + 8 * fq;
#pragma unroll
        for (int ai = 0; ai < 2; ++ai)
#pragma unroll
            for (int m = 0; m < 4; ++m) { const f32x4 g0 = acc[ai][0][m][0], g1 = acc[ai][0][m][1], u0 = acc[ai][1][m][0], u1 = acc[ai][1][m][1];
                u32x4 w; w.x = cvt_pk_bf16(sw(g0[0], u0[0]), sw(g0[1], u0[1])); w.y = cvt_pk_bf16(sw(g0[2], u0[2]), sw(g0[3], u0[3]));
                w.z = cvt_pk_bf16(sw(g1[0], u1[0]), sw(g1[1], u1[1])); w.w = cvt_pk_bf16(sw(g1[2], u1[2]), sw(g1[3], u1[3]));
                __builtin_nontemporal_store(w, (u32x4*)(p0 + (size_t)(ai * HALF + m * 16) * 64)); }
    }
};

__device__ __forceinline__ void wht8(float (&a)[8]) {
#pragma unroll
    for (int st = 1; st < 8; st <<= 1)
#pragma unroll
        for (int i = 0; i < 8; ++i) if (!(i & st)) { const float x = a[i], y = a[i | st]; a[i] = x + y; a[i | st] = x - y; }
#pragma unroll
    for (int i = 0; i < 8; ++i) a[i] *= 0.35355339059327373f;
}
struct EpiKV8 {
    static constexpr bool PERM = true; bf16_t* QKV; const float* sA; const float* sW;
    __device__ __forceinline__ void operator()(const f32x4 (&acc)[2][2][4][2], const Unit& u, int wr, int wc, int fr, int fq) const {
        typedef int v4i_ __attribute__((ext_vector_type(4)));
        const int t = u.pn >> 3, colt = (u.pn & 7) * 256, row0 = u.pm * 256 + wr * 64 + fr, col0 = colt + wc * 32 + 8 * fq;
        const float* swp = sW + (size_t)(u.pn - 8) * 256 + wc * 32 + 8 * fq;
        f32x4 sc[2][2];
#pragma unroll
        for (int bj = 0; bj < 2; ++bj)
#pragma unroll
            for (int n = 0; n < 2; ++n) sc[bj][n] = *(const f32x4*)(swp + bj * HALF + 4 * n);
        bf16_t* p0 = QKV + (size_t)t * NTOK * DATT + (size_t)row0 * DATT + col0;
#pragma unroll
        for (int ai = 0; ai < 2; ++ai)
#pragma unroll
            for (int m = 0; m < 4; ++m) { bf16_t* rowp = p0 + (size_t)(ai * HALF + m * 16) * DATT; const float sr = sA[row0 + ai * HALF + m * 16];
#pragma unroll
                for (int bj = 0; bj < 2; ++bj) { const v4i_ i0 = __builtin_bit_cast(v4i_, acc[ai][bj][m][0]), i1 = __builtin_bit_cast(v4i_, acc[ai][bj][m][1]); f32x4 v0, v1;
#pragma unroll
                    for (int e = 0; e < 4; ++e) { v0[e] = (float)i0[e] * (sr * sc[bj][0][e]); v1[e] = (float)i1[e] * (sr * sc[bj][1][e]); }
                    u32x4 w; w.x = cvt_pk_bf16(v0[0], v0[1]); w.y = cvt_pk_bf16(v0[2], v0[3]); w.z = cvt_pk_bf16(v1[0], v1[1]); w.w = cvt_pk_bf16(v1[2], v1[3]);
                    *(u32x4*)(rowp + bj * HALF) = w; } }
    }
};
struct EpiQ8 {
    static constexpr bool PERM = true; bf16_t* Q; const float* sA; const float* sW;
    __device__ __forceinline__ void operator()(const f32x4 (&acc)[2][2][4][2], const Unit& u, int wr, int wc, int fr, int fq) const {
        typedef int v4i_ __attribute__((ext_vector_type(4)));
        const int row0 = u.pm * 256 + wr * 64 + fr, col0 = u.pn * 256 + wc * 32 + 8 * fq;
        f32x4 sc[2][2];
#pragma unroll
        for (int bj = 0; bj < 2; ++bj)
#pragma unroll
            for (int n = 0; n < 2; ++n) sc[bj][n] = *(const f32x4*)(sW + col0 + bj * HALF + 4 * n);
        bf16_t* p0 = Q + (size_t)row0 * DATT + col0;
#pragma unroll
        for (int ai = 0; ai < 2; ++ai)
#pragma unroll
            for (int m = 0; m < 4; ++m) { bf16_t* rowp = p0 + (size_t)(ai * HALF + m * 16) * DATT; const float sr = sA[row0 + ai * HALF + m * 16];
#pragma unroll
                for (int bj = 0; bj < 2; ++bj) { const v4i_ i0 = __builtin_bit_cast(v4i_, acc[ai][bj][m][0]), i1 = __builtin_bit_cast(v4i_, acc[ai][bj][m][1]); f32x4 v0, v1;
#pragma unroll
                    for (int e = 0; e < 4; ++e) { v0[e] = (float)i0[e] * (sr * sc[bj][0][e]); v1[e] = (float)i1[e] * (sr * sc[bj][1][e]); }
                    u32x4 w; w.x = cvt_pk_bf16(v0[0], v0[1]); w.y = cvt_pk_bf16(v0[2], v0[3]); w.z = cvt_pk_bf16(v1[0], v1[1]); w.w = cvt_pk_bf16(v1[2], v1[3]);
                    *(u32x4*)(rowp + bj * HALF) = w; } }
    }
};
struct EpiUT8 {
    static constexpr bool PERM = true; bf16_t* UT; const float* sRow; const float* sCol;
    __device__ __forceinline__ void operator()(const f32x4 (&acc)[2][2][4][2], const Unit& u, int wr, int wc, int fr, int fq) const {
        typedef int v4i_ __attribute__((ext_vector_type(4)));
        const int row0 = u.pm * 256 + wr * 64 + fr, col0 = u.pn * 256 + wc * 32 + 8 * fq;
        f32x4 sc[2][2];
#pragma unroll
        for (int bj = 0; bj < 2; ++bj)
#pragma unroll
            for (int n = 0; n < 2; ++n) sc[bj][n] = *(const f32x4*)(sCol + col0 + bj * HALF + 4 * n);
        bf16_t* p0 = UT + (size_t)row0 * NTOK + col0;
#pragma unroll
        for (int ai = 0; ai < 2; ++ai)
#pragma unroll
            for (int m = 0; m < 4; ++m) { bf16_t* rowp = p0 + (size_t)(ai * HALF + m * 16) * NTOK; const float sr = sRow[row0 + ai * HALF + m * 16];
#pragma unroll
                for (int bj = 0; bj < 2; ++bj) { const v4i_ i0 = __builtin_bit_cast(v4i_, acc[ai][bj][m][0]), i1 = __builtin_bit_cast(v4i_, acc[ai][bj][m][1]); f32x4 v0, v1;
#pragma unroll
                    for (int e = 0; e < 4; ++e) { v0[e] = (float)i0[e] * (sr * sc[bj][0][e]); v1[e] = (float)i1[e] * (sr * sc[bj][1][e]); }
                    u32x4 w; w.x = cvt_pk_bf16(v0[0], v0[1]); w.y = cvt_pk_bf16(v0[2], v0[3]); w.z = cvt_pk_bf16(v1[0], v1[1]); w.w = cvt_pk_bf16(v1[2], v1[3]);
                    *(u32x4*)(rowp + bj * HALF) = w; } }
    }
};
struct EpiDelta8 {
    static constexpr bool PERM = true; bf16_t* Dl; const float* gate; const float* sA; const float* sW;
    __device__ __forceinline__ void operator()(const f32x4 (&acc)[2][2][4][2], const Unit& u, int wr, int wc, int fr, int fq) const {
        typedef int v4i_ __attribute__((ext_vector_type(4)));
        const int bidx = u.pm < 32 ? 0 : 1 + ((u.pm - 32) >> 3);
        const int col0 = u.pn * 256 + wc * 32 + 8 * fq;
        const float* gp = gate + (size_t)bidx * MODW + col0; const float* swp = sW + col0;
        f32x4 gv[2][2];
#pragma unroll
        for (int bj = 0; bj < 2; ++bj)
#pragma unroll
            for (int n = 0; n < 2; ++n) gv[bj][n] = *(const f32x4*)(gp + bj * HALF + 4 * n) * *(const f32x4*)(swp + bj * HALF + 4 * n);
        bf16_t* p0 = Dl + (size_t)(u.pm * 256 + wr * 64 + fr) * DM + col0; const float* sap = sA + (size_t)u.pm * 256 + wr * 64 + fr;
#pragma unroll
        for (int ai = 0; ai < 2; ++ai)
#pragma unroll
            for (int m = 0; m < 4; ++m) { bf16_t* rowp = p0 + (size_t)(ai * HALF + m * 16) * DM; const float sa = sap[ai * HALF + m * 16];
#pragma unroll
                for (int bj = 0; bj < 2; ++bj) { const v4i_ i0 = __builtin_bit_cast(v4i_, acc[ai][bj][m][0]), i1 = __builtin_bit_cast(v4i_, acc[ai][bj][m][1]); f32x4 v0, v1;
#pragma unroll
                    for (int e = 0; e < 4; ++e) { v0[e] = (float)i0[e] * (sa * gv[bj][0][e]); v1[e] = (float)i1[e] * (sa * gv[bj][1][e]); }
                    u32x4 w; w.x = cvt_pk_bf16(v0[0], v0[1]); w.y = cvt_pk_bf16(v0[2], v0[3]); w.z = cvt_pk_bf16(v1[0], v1[1]); w.w = cvt_pk_bf16(v1[2], v1[3]);
                    *(u32x4*)(rowp + bj * HALF) = w; } }
    }
};
struct EpiSwiglu8 {
    static constexpr bool PERM = true; bf16_t* ACT; const float* sA; const float* sW;
    __device__ __forceinline__ void operator()(const f32x4 (&acc)[2][2][4][2], const Unit& u, int wr, int wc, int fr, int fq) const {
        typedef int v4i_ __attribute__((ext_vector_type(4)));
        bf16_t* p0 = ACT + (size_t)(u.pm * 256 + wr * 64 + fr) * DFF + u.pn * 128 + wc * 32 + 8 * fq;
        const float* swp = sW + (size_t)u.pn * 256 + wc * 32 + 8 * fq;
        const f32x4 sg0 = *(const f32x4*)swp, sg1 = *(const f32x4*)(swp + 4), su0 = *(const f32x4*)(swp + HALF), su1 = *(const f32x4*)(swp + HALF + 4);
        const float* sap = sA + (size_t)u.pm * 256 + wr * 64 + fr;
#pragma unroll
        for (int ai = 0; ai < 2; ++ai)
#pragma unroll
            for (int m = 0; m < 4; ++m) { const float sa = sap[ai * HALF + m * 16];
                const v4i_ ig0 = __builtin_bit_cast(v4i_, acc[ai][0][m][0]), ig1 = __builtin_bit_cast(v4i_, acc[ai][0][m][1]), iu0 = __builtin_bit_cast(v4i_, acc[ai][1][m][0]), iu1 = __builtin_bit_cast(v4i_, acc[ai][1][m][1]);
                float a[8];
#pragma unroll
                for (int e = 0; e < 4; ++e) { a[e] = EpiSwiglu::sw((float)ig0[e] * (sa * sg0[e]), (float)iu0[e] * (sa * su0[e])); a[4 + e] = EpiSwiglu::sw((float)ig1[e] * (sa * sg1[e]), (float)iu1[e] * (sa * su1[e])); }
                u32x4 w; w.x = cvt_pk_bf16(a[0], a[1]); w.y = cvt_pk_bf16(a[2], a[3]); w.z = cvt_pk_bf16(a[4], a[5]); w.w = cvt_pk_bf16(a[6], a[7]);
                __builtin_nontemporal_store(w, (u32x4*)(p0 + (size_t)(ai * HALF + m * 16) * DFF)); }
    }
};

template <class Epi, class Sched, bool ALIGN_EPI, bool I8 = false>
__device__ __forceinline__ void gemm_phase(PG8_LAS unsigned char* lds, const Gemm g, const Sched& S, const Epi& E) {
    const int tid = threadIdx.x, wid = __builtin_amdgcn_readfirstlane(tid >> 6), lane = tid & 63, wr = wid >> 2, wc = wid & 3, fr = lane & 15, fq = lane >> 4;
    const int K = g.K, nt = K / BK;
    unsigned voffA[2], voffB[2];
#pragma unroll
    for (int i = 0; i < 2; ++i) { int R, C; stage_rc(tid * 16 + i * 8192, R, C); const int Rb = Epi::PERM ? ((R & ~31) + perm32(R & 31)) : R;
        voffA[i] = (unsigned)(R * g.lda + C) * 2u; voffB[i] = (unsigned)(Rb * g.ldb + C) * 2u; }
    const size_t kstepA = g.kstepA, kstepB = g.kstepB, hstepA = g.hstepA, hstepB = g.hstepB;
    const unsigned ldsw = (unsigned)wid * 1024u;
    const int aoff = lds_byte(wr * 64 + fr, fq * 8), boff = lds_byte(wc * 32 + fr, fq * 8);
#define PG8_SA(b, h) (((b) * 2 + (h)) * HTB)
#define PG8_SB(b, h) ((4 + (b) * 2 + (h)) * HTB)
#define PG8_STAGE(bufoff, gbase, voff) do { _Pragma("unroll") for (int _i = 0; _i < 2; ++_i) \
        __builtin_amdgcn_global_load_lds((const unsigned*)((const char*)(gbase) + (voff)[_i]), (PG8_LAS unsigned*)(lds + (bufoff) + ldsw + _i * 8192), 16, 0, 0); } while (0)
#define PG8_STAGEB(bufoff, gbase, voff) do { _Pragma("unroll") for (int _i = 0; _i < 2; ++_i) \
        __builtin_amdgcn_global_load_lds((const unsigned*)((const char*)(gbase) + (voff)[_i]), (PG8_LAS unsigned*)(lds + (bufoff) + ldsw + _i * 8192), 16, 0, 0); } while (0)
#define PG8_LDA(dst, b, h) do { _Pragma("unroll") for (int m = 0; m < 4; ++m) _Pragma("unroll") for (int k = 0; k < 2; ++k) dst[m][k] = *(const PG8_LAS bf16x8*)(lds + PG8_SA(b, h) + aoff + m * 2048 + k * 1024); } while (0)
#define PG8_LDB(dst, b, h) do { _Pragma("unroll") for (int n = 0; n < 2; ++n) _Pragma("unroll") for (int k = 0; k < 2; ++k) dst[n][k] = *(const PG8_LAS bf16x8*)(lds + PG8_SB(b, h) + boff + n * 2048 + k * 1024); } while (0)
#define PG8_MMA(ai, bj, At, Bt) do { __builtin_amdgcn_s_setprio(1); _Pragma("unroll") for (int m = 0; m < 4; ++m) _Pragma("unroll") for (int n = 0; n < 2; ++n) _Pragma("unroll") for (int k = 0; k < 2; ++k) { \
        if constexpr (I8) { typedef int v4i_ __attribute__((ext_vector_type(4))); \
            acc[ai][bj][m][n] = __builtin_bit_cast(f32x4, __builtin_amdgcn_mfma_i32_16x16x64_i8(__builtin_bit_cast(v4i_, Bt[n][k]), __builtin_bit_cast(v4i_, At[m][k]), __builtin_bit_cast(v4i_, acc[ai][bj][m][n]), 0, 0, 0)); } \
        else acc[ai][bj][m][n] = __builtin_amdgcn_mfma_f32_16x16x32_bf16(Bt[n][k], At[m][k], acc[ai][bj][m][n], 0, 0, 0); } __builtin_amdgcn_s_setprio(0); } while (0)
#define PG8_WAIT_V(n) asm volatile("s_waitcnt vmcnt(" #n ")" ::: "memory")
#define PG8_WAIT_L(n) asm volatile("s_waitcnt lgkmcnt(" #n ")" ::: "memory")
#define PG8_BAR __builtin_amdgcn_s_barrier()
#define PG8_SCHED __builtin_amdgcn_sched_barrier(0)
    Unit cur, nxt; int ui = 0;
    if (!S.next(0, cur)) return;
    f32x4 acc[2][2][4][2];
#pragma unroll
    for (int a = 0; a < 2; ++a)
#pragma unroll
        for (int b = 0; b < 2; ++b)
#pragma unroll
            for (int m = 0; m < 4; ++m)
#pragma unroll
                for (int n = 0; n < 2; ++n) acc[a][b][m][n] = (f32x4){0.f, 0.f, 0.f, 0.f};
    bf16x8 At[4][2], B0[2][2], B1[2][2];
    const char* cA = cur.a; const char* cB = cur.b;
    PG8_STAGEB(PG8_SB(0, 0), cB, voffB); PG8_STAGEB(PG8_SB(0, 1), cB + hstepB, voffB); PG8_STAGE(PG8_SA(0, 0), cA, voffA); PG8_STAGE(PG8_SA(0, 1), cA + hstepA, voffA);
    if (wr == 1) PG8_BAR;
    PG8_WAIT_V(2); PG8_BAR;
    PG8_STAGEB(PG8_SB(1, 0), cB + kstepB, voffB); PG8_STAGE(PG8_SA(1, 0), cA + kstepA, voffA); PG8_STAGEB(PG8_SB(1, 1), cB + hstepB + kstepB, voffB);
    PG8_WAIT_V(6); PG8_BAR;
    for (;;) {
        const bool has_next = S.next(ui + 1, nxt);
        const char* nA = has_next ? nxt.a : cA; const char* nB = has_next ? nxt.b : cB;
        for (int t = 0; t < nt; t += 2) {
            const bool last = (t == nt - 2);
            const char* a1 = cA + (size_t)(t + 1) * kstepA;
            const char* a2 = last ? nA : cA + (size_t)(t + 2) * kstepA; const char* b2 = last ? nB : cB + (size_t)(t + 2) * kstepB;
            const char* a3 = a2 + kstepA; const char* b3 = b2 + kstepB;
            PG8_LDB(B0, 0, 0); PG8_LDB(B1, 0, 1); PG8_SCHED; PG8_LDA(At, 0, 0); PG8_STAGE(PG8_SA(1, 1), a1 + hstepA, voffA);
            PG8_WAIT_V(8); PG8_WAIT_L(0); PG8_BAR; PG8_MMA(0, 0, At, B0); PG8_MMA(0, 1, At, B1); PG8_BAR; PG8_SCHED;
            PG8_LDA(At, 0, 1); PG8_STAGEB(PG8_SB(0, 0), b2, voffB); PG8_STAGEB(PG8_SB(0, 1), b2 + hstepB, voffB); PG8_STAGE(PG8_SA(0, 0), a2, voffA);
            PG8_WAIT_V(8); PG8_WAIT_L(0); PG8_BAR; PG8_MMA(1, 0, At, B0); PG8_MMA(1, 1, At, B1); PG8_BAR; PG8_SCHED;
            PG8_LDB(B0, 1, 0); PG8_LDB(B1, 1, 1); PG8_SCHED; PG8_LDA(At, 1, 0); PG8_STAGE(PG8_SA(0, 1), a2 + hstepA, voffA);
            PG8_WAIT_V(8); PG8_WAIT_L(0); PG8_BAR; PG8_MMA(0, 0, At, B0); PG8_MMA(0, 1, At, B1); PG8_BAR; PG8_SCHED;
            PG8_LDA(At, 1, 1); PG8_STAGEB(PG8_SB(1, 0), b3, voffB); PG8_STAGEB(PG8_SB(1, 1), b3 + hstepB, voffB); PG8_STAGE(PG8_SA(1, 0), a3, voffA);
            PG8_WAIT_V(8); PG8_WAIT_L(0); PG8_BAR; PG8_MMA(1, 0, At, B0); PG8_MMA(1, 1, At, B1); PG8_BAR; PG8_SCHED;
        }
        if constexpr (ALIGN_EPI) { if (wr == 0) PG8_BAR; }
        E(acc, cur, wr, wc, fr, fq);
        if (!has_next) break;
#pragma unroll
        for (int a = 0; a < 2; ++a)
#pragma unroll
            for (int b = 0; b < 2; ++b)
#pragma unroll
                for (int m = 0; m < 4; ++m)
#pragma unroll
                    for (int n = 0; n < 2; ++n) acc[a][b][m][n] = (f32x4){0.f, 0.f, 0.f, 0.f};
        cur = nxt; cA = nA; cB = nB; ++ui;
        if constexpr (ALIGN_EPI) { if (wr == 1) PG8_BAR; }
    }
    PG8_WAIT_V(0);
    if constexpr (!ALIGN_EPI) { if (wr == 0) PG8_BAR; }
    PG8_BAR;
#undef PG8_SA
#undef PG8_SB
#undef PG8_STAGE
#undef PG8_STAGEB
#undef PG8_LDA
#undef PG8_LDB
#undef PG8_MMA
#undef PG8_WAIT_V
#undef PG8_WAIT_L
#undef PG8_BAR
#undef PG8_SCHED
}
}

namespace att {
using bf16x8 = __attribute__((ext_vector_type(8))) short;
using s16x4  = __attribute__((ext_vector_type(4))) short;
using f32x16 = __attribute__((ext_vector_type(16))) float;
using u32x4  = __attribute__((ext_vector_type(4))) unsigned;
constexpr int D = 128, NW = 8, QBLK = 32, KVBLK = 64;
constexpr float SCALE = 0.088388347648318440f;
constexpr float THR = 8.f;
constexpr int LDQ = DATT, LDK = DATT, LDO = DM;
constexpr size_t SHM_V = KVBLK * D * 2, SHM_K = KVBLK * D * 2;
constexpr int OFF_WS = 2 * SHM_V + 2 * SHM_K, OFF_TAB = OFF_WS + NW * 64 * 4, OFF_OST = OFF_TAB + 15 * 128 * 4, OST_PITCH = 272, OST_WAVE = 32 * OST_PITCH, SHM_ATTN = OFF_OST + NW * OST_WAVE;
constexpr float NEG = -1e30f, M_INIT = -1e4f;
#define KSWZ(row, colB) ((row) * 256 + ((colB) ^ (((row) & 7) << 4)))
#define SBAR() __builtin_amdgcn_sched_barrier(0)
__device__ __forceinline__ int crow(int r, int hi) { return (r & 3) + 8 * (r >> 2) + 4 * hi; }
__device__ __forceinline__ unsigned cvtpk(float lo, float hi) { unsigned r; asm volatile("v_cvt_pk_bf16_f32 %0, %1, %2" : "=v"(r) : "v"(lo), "v"(hi)); return r; }

__device__ __forceinline__ void partialSM(f32x16& p0, f32x16& p1, float& m_reg, float& mn, float& alpha) {
  constexpr float C = SCALE * 1.4426950408889634f;
  float pmax = p0[0];
#pragma unroll
  for (int r = 1; r < 16; ++r) pmax = fmaxf(pmax, p0[r]);
#pragma unroll
  for (int r = 0; r < 16; ++r) pmax = fmaxf(pmax, p1[r]);
  { auto rr = __builtin_amdgcn_permlane32_swap(__float_as_uint(pmax), __float_as_uint(pmax), false, false);
    pmax = fmaxf(__uint_as_float(rr[0]), __uint_as_float(rr[1])); }
  if (__builtin_expect(__all(pmax - m_reg <= THR / SCALE), 1)) { mn = m_reg; alpha = 1.f; }
  else { mn = fmaxf(m_reg, pmax); alpha = __builtin_amdgcn_exp2f((m_reg - mn) * C); m_reg = mn; }
  float mnC = -mn * C;
#pragma unroll
  for (int r = 0; r < 16; ++r) p0[r] = fmaf(p0[r], C, mnC);
#pragma unroll
  for (int r = 0; r < 16; ++r) p1[r] = fmaf(p1[r], C, mnC);
#pragma unroll
  for (int r = 0; r < 16; ++r) p0[r] = __builtin_amdgcn_exp2f(p0[r]);
}
__device__ __forceinline__ void finishSM(f32x16& p0, f32x16& p1, float alpha, float& l_reg, bf16x8& pa0, bf16x8& pa1, bf16x8& pa2, bf16x8& pa3) {
#pragma unroll
  for (int r = 0; r < 16; ++r) p1[r] = __builtin_amdgcn_exp2f(p1[r]);
  float ps = 0;
#pragma unroll
  for (int r = 0; r < 16; ++r) ps += p0[r];
#pragma unroll
  for (int r = 0; r < 16; ++r) ps += p1[r];
  { auto rr = __builtin_amdgcn_permlane32_swap(__float_as_uint(ps), __float_as_uint(ps), false, false);
    ps = __uint_as_float(rr[0]) + __uint_as_float(rr[1]); }
  l_reg = l_reg * alpha + ps;
#define PK4(P, BASE, OUT) do { unsigned a0 = cvtpk(P[BASE + 0], P[BASE + 1]), a1 = cvtpk(P[BASE + 2], P[BASE + 3]);   \
    unsigned b0 = cvtpk(P[BASE + 4], P[BASE + 5]), b1 = cvtpk(P[BASE + 6], P[BASE + 7]);                              \
    auto r0 = __builtin_amdgcn_permlane32_swap(a0, b0, false, false); auto r1 = __builtin_amdgcn_permlane32_swap(a1, b1, false, false); \
    u32x4 w = {r0[0], r1[0], r0[1], r1[1]}; OUT = *reinterpret_cast<bf16x8*>(&w); } while (0)
  PK4(p0, 0, pa0); PK4(p0, 8, pa1); PK4(p1, 0, pa2); PK4(p1, 8, pa3);
#undef PK4
}
__device__ __forceinline__ void qkt(f32x16& p0, f32x16& p1, const char* Ks, const bf16x8* qr, int r32, int hi) {
  p0 = f32x16{}; p1 = f32x16{};
#pragma unroll
  for (int d0 = 0; d0 < 8; ++d0) { int cb = (d0 * 16 + hi * 8) * 2;
    bf16x8 b0 = *reinterpret_cast<const bf16x8*>(Ks + KSWZ(r32, cb));
    bf16x8 b1 = *reinterpret_cast<const bf16x8*>(Ks + KSWZ(32 + r32, cb));
    p0 = __builtin_amdgcn_mfma_f32_32x32x16_bf16(b0, qr[d0], p0, 0, 0, 0);
    p1 = __builtin_amdgcn_mfma_f32_32x32x16_bf16(b1, qr[d0], p1, 0, 0, 0); }
}
__device__ __forceinline__ int v_st(int k, int c) { const int kk = (k & ~0xC) | ((k & 4) << 1) | ((k & 8) >> 1); return ((kk >> 3) * 4 + (c >> 5)) * 512 + ((kk & 7) * 32 + (c & 31)) * 2; }
__device__ __forceinline__ int v_rd_base(int lane) { return ((lane & 3) << 3) | (((lane >> 2) & 3) << 6) | (((lane >> 4) & 1) << 5) | (((lane >> 5) & 1) << 8); }
constexpr int v_rd_off(int d0, int ks, int half) { return d0 * 512 + ks * 4096 + half * 2048; }
template <int OFF> __device__ __forceinline__ s16x4 tr_read(int vb) {
  s16x4 r; asm volatile("ds_read_b64_tr_b16 %0, %1 offset:%2" : "=&v"(r) : "v"(vb), "i"(OFF) : "memory"); return r;
}
template <int D0> __device__ __forceinline__ void pv_one(f32x16& od, int vb, bf16x8 pa0, bf16x8 pa1, bf16x8 pa2, bf16x8 pa3) {
  const s16x4 l0 = tr_read<v_rd_off(D0, 0, 0)>(vb), h0 = tr_read<v_rd_off(D0, 0, 1)>(vb), l1 = tr_read<v_rd_off(D0, 1, 0)>(vb), h1 = tr_read<v_rd_off(D0, 1, 1)>(vb);
  const s16x4 l2 = tr_read<v_rd_off(D0, 2, 0)>(vb), h2 = tr_read<v_rd_off(D0, 2, 1)>(vb), l3 = tr_read<v_rd_off(D0, 3, 0)>(vb), h3 = tr_read<v_rd_off(D0, 3, 1)>(vb);
  asm volatile("s_waitcnt lgkmcnt(0)" ::: "memory"); SBAR();
#define PK(L, H) (bf16x8){L[0], L[1], L[2], L[3], H[0], H[1], H[2], H[3]}
  od = __builtin_amdgcn_mfma_f32_32x32x16_bf16(pa0, PK(l0, h0), od, 0, 0, 0);
  od = __builtin_amdgcn_mfma_f32_32x32x16_bf16(pa1, PK(l1, h1), od, 0, 0, 0);
  od = __builtin_amdgcn_mfma_f32_32x32x16_bf16(pa2, PK(l2, h2), od, 0, 0, 0);
  od = __builtin_amdgcn_mfma_f32_32x32x16_bf16(pa3, PK(l3, h3), od, 0, 0, 0);
#undef PK
}
__device__ __forceinline__ void pv_d0(f32x16* o, int vb, bf16x8 pa0, bf16x8 pa1, bf16x8 pa2, bf16x8 pa3) {
  pv_one<0>(o[0], vb, pa0, pa1, pa2, pa3); pv_one<1>(o[1], vb, pa0, pa1, pa2, pa3); pv_one<2>(o[2], vb, pa0, pa1, pa2, pa3); pv_one<3>(o[3], vb, pa0, pa1, pa2, pa3);
}

struct AttnUnit { const bf16* Q; const bf16* K0; const bf16* V0; const bf16* K1; const bf16* V1; bf16* O; const float* rpbh; int n0, n1, r0, kr0; };

template <bool NEIGH>
__device__ __forceinline__ void attn_unit(const AttnUnit& U, char* lds) {
  const int tid = threadIdx.x, wid = tid >> 6, lane = tid & 63, r32 = lane & 31, hi = lane >> 5;
  char* V_lds = lds; char* K_lds = lds + 2 * SHM_V;
  float* ws = (float*)(lds + OFF_WS) + wid * 64; float* li_l = ws; float* al_l = ws + 32;
  float* tab = (float*)(lds + OFF_TAB);
  __syncthreads();
  if (NEIGH) { for (int i = tid; i < 15 * 128; i += 512) { const int dr = i >> 7, dc = (i & 127) - 48; tab[i] = (dc >= 0 && dc < 31) ? U.rpbh[dr * 31 + dc] * (1.0f / SCALE) : 0.f; } }
  float m_reg = M_INIT, l_reg = 0; f32x16 o[4] = {}; bf16x8 qr[8];
  const bf16* Qw = U.Q + (long)(wid * QBLK + r32) * LDQ + hi * 8;
#pragma unroll
  for (int d0 = 0; d0 < 8; ++d0) qr[d0] = *reinterpret_cast<const bf16x8*>(Qw + d0 * 16);
  const int sr = tid >> 4, sc = (tid & 15) * 8, vst0 = v_st(sr, sc), vst1 = v_st(32 + sr, sc);
  const int vb0 = (int)(uintptr_t)V_lds + v_rd_base(lane);
  const int qrow = U.r0 + (wid >> 1), rs = min(max(qrow - 4, 0), 24), qc = (wid & 1) * 32 + r32, cs = min(max(qc - 8, 0), 48);
  struct { bf16x8 vs0, vs1, ks0, ks1; } sr_[2];
  const int n0 = U.n0, NT = U.n0 + U.n1;
#define KPTR(j) ((j) < n0 ? U.K0 + (long)(j) * KVBLK * LDK : U.K1 + (long)((j) - n0) * KVBLK * LDK)
#define VPTR(j) ((j) < n0 ? U.V0 + (long)(j) * KVBLK * LDK : U.V1 + (long)((j) - n0) * KVBLK * LDK)
#define SLOAD(i, j) do { const bf16* kp_ = KPTR(j); const bf16* vp_ = VPTR(j); \
    sr_[i].vs0 = *reinterpret_cast<const bf16x8*>(&vp_[(long)sr * LDK + sc]); sr_[i].vs1 = *reinterpret_cast<const bf16x8*>(&vp_[(long)(32 + sr) * LDK + sc]); \
    sr_[i].ks0 = *reinterpret_cast<const bf16x8*>(&kp_[(long)sr * LDK + sc]); sr_[i].ks1 = *reinterpret_cast<const bf16x8*>(&kp_[(long)(32 + sr) * LDK + sc]); } while (0)
#define SWRITE(b, i) do { *(bf16x8*)(V_lds + (b) * SHM_V + vst0) = sr_[i].vs0; *(bf16x8*)(V_lds + (b) * SHM_V + vst1) = sr_[i].vs1; int kc = sc * 2; \
    *(bf16x8*)(K_lds + (b) * SHM_K + KSWZ(sr, kc)) = sr_[i].ks0; *(bf16x8*)(K_lds + (b) * SHM_K + KSWZ(32 + sr, kc)) = sr_[i].ks1; } while (0)
#define SWAIT() asm volatile("s_waitcnt vmcnt(4)" ::: "memory")
#define RESC(a) do { if (__any((a) < 1.f)) { if (hi == 0) al_l[r32] = (a); asm volatile("s_waitcnt lgkmcnt(0)" ::: "memory"); \
    _Pragma("unroll") for (int d = 0; d < 4; ++d) _Pragma("unroll") for (int r = 0; r < 16; ++r) o[d][r] *= al_l[crow(r, hi)]; } } while (0)
#define BIASMASK(P0, P1, j) do { if (NEIGH && (j) < n0) { const int kr_ = U.kr0 + (j); \
    if ((unsigned)(kr_ - rs) < 8u) { const float* trow_ = tab + (kr_ - qrow + 7) * 128 + (63 - qc + 4 * hi); const int cb_ = 4 * hi - cs; \
      _Pragma("unroll") for (int r = 0; r < 16; ++r) { const int kc_ = (r & 3) + 8 * (r >> 2); \
        P0[r] = ((unsigned)(cb_ + kc_) < 16u) ? P0[r] + trow_[kc_] : NEG; \
        P1[r] = ((unsigned)(cb_ + kc_ + 32) < 16u) ? P1[r] + trow_[kc_ + 32] : NEG; \
        if ((r & 3) == 3) asm volatile("" ::: "memory"); } } \
    else { _Pragma("unroll") for (int r = 0; r < 16; ++r) { P0[r] = NEG; P1[r] = NEG; } } } } while (0)
  f32x16 pA0, pA1, pB0, pB1; float mnA, mnB, alA, alB; bf16x8 pa0, pa1, pa2, pa3;
  constexpr int SE = 0, SO = 1;
  SLOAD(SE, 0); asm volatile("s_waitcnt vmcnt(0)" ::: "memory"); SWRITE(0, SE); __syncthreads();
  qkt(pA0, pA1, K_lds, qr, r32, hi); BIASMASK(pA0, pA1, 0); partialSM(pA0, pA1, m_reg, mnA, alA);
  SLOAD(SO, 1); if (2 < NT) SLOAD(SE, 2);
  SWAIT(); SWRITE(1, SO); __syncthreads();
  for (int j = 1; j + 1 < NT; j += 2) {
    SBAR(); qkt(pB0, pB1, K_lds + SHM_K, qr, r32, hi);
    finishSM(pA0, pA1, alA, l_reg, pa0, pa1, pa2, pa3); SBAR();
    SLOAD(SO, j + 2); SBAR();
    pv_d0(o, vb0, pa0, pa1, pa2, pa3); BIASMASK(pB0, pB1, j); partialSM(pB0, pB1, m_reg, mnB, alB);
    __syncthreads(); SWAIT(); SWRITE(0, SE);
    RESC(alB); __syncthreads();
    SBAR(); qkt(pA0, pA1, K_lds, qr, r32, hi);
    finishSM(pB0, pB1, alB, l_reg, pa0, pa1, pa2, pa3); SBAR();
    if (j + 3 < NT) SLOAD(SE, j + 3); SBAR();
    pv_d0(o, vb0 + (int)SHM_V, pa0, pa1, pa2, pa3); BIASMASK(pA0, pA1, j + 1); partialSM(pA0, pA1, m_reg, mnA, alA);
    __syncthreads(); SWAIT(); SWRITE(1, SO);
    RESC(alA); __syncthreads();
  }
  SBAR(); qkt(pB0, pB1, K_lds + SHM_K, qr, r32, hi);
  finishSM(pA0, pA1, alA, l_reg, pa0, pa1, pa2, pa3); SBAR();
  pv_d0(o, vb0, pa0, pa1, pa2, pa3); BIASMASK(pB0, pB1, NT - 1); partialSM(pB0, pB1, m_reg, mnB, alB);
  __syncthreads(); RESC(alB);
  finishSM(pB0, pB1, alB, l_reg, pa0, pa1, pa2, pa3); SBAR();
  pv_d0(o, vb0 + (int)SHM_V, pa0, pa1, pa2, pa3);
  if (hi == 0) li_l[r32] = l_reg; asm volatile("s_waitcnt lgkmcnt(0)" ::: "memory");
  float rli[16];
#pragma unroll
  for (int r = 0; r < 16; ++r) rli[r] = __builtin_amdgcn_rcpf(li_l[crow(r, hi)]);
  char* ost = lds + OFF_OST + wid * OST_WAVE;
#pragma unroll
  for (int r = 0; r < 16; ++r) { const int orow = crow(r, hi);
#pragma unroll
    for (int d0 = 0; d0 < 4; ++d0) { const float v = o[d0][r] * rli[r]; *(bf16*)(ost + orow * OST_PITCH + (d0 * 32 + r32) * 2) = (bf16)(cvtpk(v, v) & 0xffffu); } }
  asm volatile("s_waitcnt lgkmcnt(0)" ::: "memory");
  { bf16* Ow = U.O + (long)(wid * QBLK + (lane >> 4)) * LDO + (lane & 15) * 8; const char* osr = ost + (lane >> 4) * OST_PITCH + (lane & 15) * 16;
#pragma unroll 1
    for (int i = 0; i < 8; ++i) { *(u32x4*)Ow = *(const u32x4*)osr; Ow += 4 * LDO; osr += 4 * OST_PITCH; } }
#undef KPTR
#undef VPTR
#undef SLOAD
#undef SWRITE
#undef SWAIT
#undef RESC
#undef BIASMASK
}
}
static_assert(att::SHM_ATTN <= LDSCTL_OFF, "attention LDS stays below the control words");

#define XB_TMO      128
#define XB_XCNT(j)  (256  + 64 * (j))
#define XB_XSUB(j)  (1280 + 64 * (j))
#define XB_XGEN(j)  (2304 + 64 * (j))
#define XB_TOP      3328
#define XB_TOPGEN   3392
#define XCD_BAR_WORDS 3456
#define XB_SPIN_CAP (1u << 18)
__device__ __forceinline__ unsigned xb_ld(unsigned* p)              { return __hip_atomic_load(p, __ATOMIC_RELAXED, __HIP_MEMORY_SCOPE_AGENT); }
__device__ __forceinline__ unsigned xb_add(unsigned* p, unsigned v) { return __hip_atomic_fetch_add(p, v, __ATOMIC_RELAXED, __HIP_MEMORY_SCOPE_AGENT); }
__device__ __forceinline__ unsigned xb_xcc_id() { return (unsigned)__builtin_amdgcn_s_getreg((3 << 11) | 20) & 0xFu; }
#define XB_SPIN(cond, bar) do { unsigned _sp = 0; while (cond) { __builtin_amdgcn_s_sleep(1); \
    if ((++_sp & 255u) == 0u) { if (xb_ld(&(bar)[XB_TMO])) break; if (_sp > XB_SPIN_CAP) { atomicAdd(&(bar)[XB_TMO], 1u); break; } } } } while (0)
struct XcdBarrier { unsigned* bar; unsigned x; volatile LAS unsigned* st; };
__device__ __forceinline__ XcdBarrier xcd_barrier_post(unsigned* bar, volatile LAS unsigned* st) {
    XcdBarrier b; b.bar = bar; b.x = xb_xcc_id(); b.st = st;
    if (threadIdx.x == 0) (void)xb_add(&bar[XB_XCNT(b.x)], 1u);
    return b;
}
__device__ __forceinline__ void xcd_barrier_complete(unsigned* bar, unsigned x, unsigned& nloc, unsigned& nx) {
    const unsigned G = gridDim.x * gridDim.y * gridDim.z;
    unsigned sum, cnt, mine, sp = 0u;
    for (;;) {
        sum = 0u; cnt = 0u; mine = 0u;
#pragma unroll
        for (unsigned j = 0; j < 16; ++j) { const unsigned c = xb_ld(&bar[XB_XCNT(j)]); sum += c; cnt += (c > 0u) ? 1u : 0u; mine = (j == x) ? c : mine; }
        if (sum == G) break;
        __builtin_amdgcn_s_sleep(1);
        if ((++sp & 255u) == 0u) { if (xb_ld(&bar[XB_TMO])) break; if (sp > XB_SPIN_CAP) { atomicAdd(&bar[XB_TMO], 1u); break; } }
    }
    nloc = mine > 0u ? mine : 1u; nx = cnt > 0u ? cnt : 1u;
}
__device__ __forceinline__ void xcd_barrier(const XcdBarrier& b) {
    asm volatile("s_waitcnt vmcnt(0)" ::: "memory");
    __syncthreads();
    if (threadIdx.x == 0) {
        unsigned* bar = b.bar;
        __builtin_amdgcn_s_waitcnt(0);
        unsigned nloc = b.st[0], nx = b.st[1];
        if (nloc == 0u) { xcd_barrier_complete(bar, b.x, nloc, nx); b.st[0] = nloc; b.st[1] = nx; }
        const unsigned old = xb_add(&bar[XB_XSUB(b.x)], 1u);
        const unsigned gen = old / nloc;
        if (old + 1u == (gen + 1u) * nloc) {
            __builtin_amdgcn_fence(__ATOMIC_RELEASE, "agent");
            asm volatile("s_waitcnt vmcnt(0)" ::: "memory");
            const unsigned og = xb_add(&bar[XB_TOP], 1u);
            const unsigned tg = og / nx;
            if (og + 1u == (tg + 1u) * nx) xb_add(&bar[XB_TOPGEN], 1u);
            else XB_SPIN(xb_ld(&bar[XB_TOPGEN]) == tg, bar);
            __builtin_amdgcn_fence(__ATOMIC_ACQUIRE, "agent");
            xb_add(&bar[XB_XGEN(b.x)], 1u);
            asm volatile("s_waitcnt vmcnt(0)" ::: "memory");
        } else {
            XB_SPIN(xb_ld(&bar[XB_XGEN(b.x)]) == gen, bar);
            __builtin_amdgcn_fence(__ATOMIC_ACQUIRE, "agent");
            asm volatile("s_waitcnt vmcnt(0)" ::: "memory");
        }
    }
    __syncthreads();
}

typedef float f32x4 __attribute__((ext_vector_type(4)));
__device__ __forceinline__ unsigned f2bf(float f) { unsigned u = __builtin_bit_cast(unsigned, f); return (u + 0x7fffu + ((u >> 16) & 1u)) >> 16; }
__device__ __forceinline__ unsigned pk2(float lo, float hi) { return f2bf(lo) | (f2bf(hi) << 16); }
__device__ __forceinline__ float wave_sum(float v) {
#pragma unroll
    for (int o = 1; o < 64; o <<= 1) v += __shfl_xor(v, o);
    return v;
}

__device__ __forceinline__ unsigned q8x4(float a, float b, float c, float d, float iv) {
    unsigned r = 0u;
    r = __builtin_amdgcn_cvt_pk_u8_f32(__builtin_rintf(a * iv + 128.0f), 0, r); r = __builtin_amdgcn_cvt_pk_u8_f32(__builtin_rintf(b * iv + 128.0f), 1, r);
    r = __builtin_amdgcn_cvt_pk_u8_f32(__builtin_rintf(c * iv + 128.0f), 2, r); r = __builtin_amdgcn_cvt_pk_u8_f32(__builtin_rintf(d * iv + 128.0f), 3, r);
    return r ^ 0x80808080u;
}
__device__ __forceinline__ f32x4 add_bf4(f32x4 v, v2u d) {
    v.x += __uint_as_float(d.x << 16); v.y += __uint_as_float(d.x & 0xffff0000u); v.z += __uint_as_float(d.y << 16); v.w += __uint_as_float(d.y & 0xffff0000u); return v; }

struct Args {
    const float *x_prompt, *x_sample, *cache_k, *cache_v, *c, *c_ctx, *w_ada, *b_ada, *norm1_g, *w_in, *rpb, *w_out, *norm2_g, *w_gate, *w_up, *w_down, *final_g;
    float* out; unsigned char* ws; int ph_lo, ph_hi;
};

struct TrItem { const float* W; bf16* WT; int N, k0, n0, drow0, dcol; unsigned ldT; bool nt; };
constexpr int TR_I_IN = 64 * 64, TR_I_OUT = 64 * 64, TR_I_G = 64 * 172, TR_I_D = 172 * 64, TR_NITEMS = TR_I_IN + TR_I_OUT + 2 * TR_I_G + TR_I_D;
__device__ __forceinline__ TrItem tr_decode(const Args& args, bf16* WinT, bf16* WoutT, bf16* WguT, bf16* WdT, int r) {
    TrItem t;
    if (r < TR_I_IN) { const int kb = r / 64, nb = 32 + r % 64; t.W = args.w_in;
        t.N = 8192; t.k0 = kb * 64; t.n0 = nb * 64; t.WT = WinT; t.ldT = DM; t.drow0 = nb * 64; t.dcol = t.k0; t.nt = false; return t; } r -= TR_I_IN;
    if (r < TR_I_OUT) { const int kb = r / 64, nb = r % 64; t.W = args.w_out; t.N = DM; t.k0 = kb * 64; t.n0 = nb * 64; t.WT = WoutT; t.ldT = DM; t.drow0 = nb * 64; t.dcol = t.k0; t.nt = true; return t; } r -= TR_I_OUT;
    if (r < 2 * TR_I_G) { const bool up = r >= TR_I_G; if (up) r -= TR_I_G; const int kb = r / 172, nb = r % 172, n0 = nb * 64;
        t.W = up ? args.w_up : args.w_gate; t.N = DFF; t.k0 = kb * 64; t.n0 = n0; t.WT = WguT; t.ldT = DM; t.drow0 = (n0 >> 7) * 256 + (n0 & 127) + (up ? 128 : 0); t.dcol = t.k0; t.nt = true; return t; } r -= 2 * TR_I_G;
    { const int kb = r / 64, nb = r % 64; t.W = args.w_down; t.N = DM; t.k0 = kb * 64; t.n0 = nb * 64; t.WT = WdT + ((size_t)((nb >> 2) * (DFF / 64) + kb) * 256 + (nb & 3) * 64) * 64; t.ldT = 64; t.drow0 = 0; t.dcol = 0; t.nt = false; return t; }
}
__device__ __forceinline__ void tr_load(const TrItem& t, f32x4 (&v)[16], int lane) {
    const int rr = lane >> 4, cc = (lane & 15) * 4;
    const GAS float* p = (const GAS float*)t.W + (size_t)(t.k0 + rr) * t.N + t.n0 + cc;
#pragma unroll
    for (int i = 0; i < 16; ++i) v[i] = __builtin_nontemporal_load((const GAS f32x4*)(p + (size_t)(4 * i) * t.N));
}
__device__ __forceinline__ void tr_to_lds(const f32x4 (&v)[16], LAS float* scr, int lane) {
    const int rr = lane >> 4, cc = (lane & 15) * 4;
#pragma unroll
    for (int i = 0; i < 16; ++i) { LAS float* s = scr + (4 * i + rr) * 65 + cc; s[0] = v[i].x; s[1] = v[i].y; s[2] = v[i].z; s[3] = v[i].w; }
}
__device__ __forceinline__ void tr_store(const TrItem& t, const LAS float* scr, int lane) {
    const int c = lane & 7;
#pragma unroll
    for (int j = 0; j < 8; ++j) { const int n = (lane >> 3) + 8 * j; const LAS float* s = scr + (8 * c) * 65 + n;
        v4u o; o.x = pk2(s[0 * 65], s[1 * 65]); o.y = pk2(s[2 * 65], s[3 * 65]); o.z = pk2(s[4 * 65], s[5 * 65]); o.w = pk2(s[6 * 65], s[7 * 65]);
        GAS v4u* dp = (GAS v4u*)(t.WT + (size_t)(t.drow0 + n) * t.ldT + t.dcol + 8 * c);
        if (t.nt) __builtin_nontemporal_store(o, dp); else *dp = o; }
}
__device__ __forceinline__ void tr_run(const Args& args, bf16* WinT, bf16* WoutT, bf16* WguT, bf16* WdT, int base, int first, int last, int stride, LAS float* scr, int lane) {
    if (first >= last) return;
    f32x4 v[16];
    TrItem cur = tr_decode(args, WinT, WoutT, WguT, WdT, base + first); tr_load(cur, v, lane);
    for (int it = first; it < last; it += stride) {
        tr_to_lds(v, scr, lane);
        LDS_WAIT(); asm volatile("" ::: "memory");
        TrItem nx = cur; const bool more = it + stride < last;
        if (more) { nx = tr_decode(args, WinT, WoutT, WguT, WdT, base + it + stride); tr_load(nx, v, lane); }
        tr_store(cur, scr, lane);
        LDS_WAIT(); asm volatile("" ::: "memory");
        cur = nx;
    }
}

__device__ __forceinline__ void ada_task(const Args& args, int col0, int kbase, int krows, float* out, size_t opitch, LAS float* scr, int lane) {
    for (int i = 0; i < krows / 64; ++i) { const int k = kbase + 64 * i + lane;
#pragma unroll
        for (int v = 0; v < NMODV; ++v) { const float cv = (v == 0) ? args.c_ctx[k] : args.c[(v - 1) * DM + k]; scr[(64 * i + lane) * 8 + v] = cv / (1.0f + expf(-cv)); } }
    LDS_WAIT(); asm volatile("" ::: "memory");
    f32x4 acc[NMODV];
#pragma unroll
    for (int v = 0; v < NMODV; ++v) acc[v] = (f32x4){0.f, 0.f, 0.f, 0.f};
    const GAS f32x4* wp = (const GAS f32x4*)(args.w_ada + (size_t)kbase * MODW + col0) + lane;
#pragma unroll 8
    for (int kk = 0; kk < krows; ++kk) { const f32x4 w = __builtin_nontemporal_load(wp + (size_t)kk * (MODW / 4)); const f32x4 s4 = *(const LAS f32x4*)(scr + kk * 8); const float s5 = scr[kk * 8 + 4];
        acc[0] += s4.x * w; acc[1] += s4.y * w; acc[2] += s4.z * w; acc[3] += s4.w * w; acc[4] += s5 * w; }
#pragma unroll
    for (int v = 0; v < NMODV; ++v) *(GAS f32x4*)(out + (size_t)v * opitch + 4 * lane) = acc[v];
    LDS_WAIT(); asm volatile("" ::: "memory");
}
__device__ __forceinline__ int gu_row(int n, bool up) { return (n >> 7) * 256 + (n & 127) + (up ? 128 : 0); }
__device__ __forceinline__ void amax_task(const float* W, int N, int col0, int ks, float* dst, int lane) {
    const GAS f32x4* wp = (const GAS f32x4*)(W + (size_t)(ks * 256) * N + col0) + lane;
    f32x4 mx = (f32x4){0.f, 0.f, 0.f, 0.f};
#pragma unroll 8
    for (int kk = 0; kk < 256; ++kk) { const f32x4 w = wp[(size_t)kk * (N / 4)]; mx.x = fmaxf(mx.x, fabsf(w.x)); mx.y = fmaxf(mx.y, fabsf(w.y)); mx.z = fmaxf(mx.z, fabsf(w.z)); mx.w = fmaxf(mx.w, fabsf(w.w)); }
    *(GAS f32x4*)dst = mx;
}
__device__ __forceinline__ void amax_task_rot(const float* W, int N, int col0, int ks, float* dst, int lane) {
    const GAS f32x4* wp = (const GAS f32x4*)(W + (size_t)(ks * 256) * N + col0) + lane;
    f32x4 mx = (f32x4){0.f, 0.f, 0.f, 0.f};
#pragma unroll 1
    for (int kk = 0; kk < 256; kk += 8) { f32x4 w[8];
#pragma unroll
        for (int e = 0; e < 8; ++e) w[e] = wp[(size_t)(kk + e) * (N / 4)];
#pragma unroll
        for (int cc = 0; cc < 4; ++cc) { float a[8];
#pragma unroll
            for (int e = 0; e < 8; ++e) a[e] = w[e][cc];
            pg8::wht8(a);
#pragma unroll
            for (int e = 0; e < 8; ++e) mx[cc] = fmaxf(mx[cc], fabsf(a[e])); } }
    *(GAS f32x4*)dst = mx;
}
template <int NPART, bool ROT>
__device__ __forceinline__ void quant_item(const float* W, int N, int kb, int n0, const float* amaxp, int apitch, signed char* Wq, size_t ldq, float* sW, LAS float* scr, int lane) {
    const int k0 = kb * 64;
    TrItem t; t.W = W; t.N = N; t.k0 = k0; t.n0 = n0; t.WT = nullptr; t.ldT = 0; t.drow0 = 0; t.dcol = 0; t.nt = false;
    f32x4 v[16]; tr_load(t, v, lane);
    LAS float* inv = scr + 64 * 65;
    if constexpr (NPART == 0) { const float sc = sW[lane]; inv[lane] = sc > 0.f ? 1.0f / sc : 0.f; }
    else { float am = 0.f;
#pragma unroll
        for (int p = 0; p < NPART; ++p) am = fmaxf(am, amaxp[(size_t)p * apitch + lane]);
        inv[lane] = am > 0.f ? 127.0f / am : 0.f;
        if (kb == 0) sW[lane] = am * (1.0f / 127.0f); }
    tr_to_lds(v, scr, lane);
    LDS_WAIT(); asm volatile("" ::: "memory");
    const int c = lane & 7;
#pragma unroll 2
    for (int j = 0; j < 8; ++j) { const int n = (lane >> 3) + 8 * j; const LAS float* sp = scr + (8 * c) * 65 + n; const float iv = inv[n];
        float a[8];
#pragma unroll
        for (int e = 0; e < 8; ++e) a[e] = sp[e * 65];
        if (ROT) pg8::wht8(a);
        v2u o; o.x = q8x4(a[0], a[1], a[2], a[3], iv); o.y = q8x4(a[4], a[5], a[6], a[7], iv);
        *(GAS v2u*)(Wq + (size_t)n * ldq + 8 * c) = o; }
    LDS_WAIT(); asm volatile("" ::: "memory");
}
__device__ __forceinline__ void quant_row_bf16(const bf16* src, signed char* dst, float* s_out, int lane) {
    const GAS v4u* sp = (const GAS v4u*)src + lane; v4u r[8]; float am = 0.f;
#pragma unroll
    for (int j = 0; j < 8; ++j) { r[j] = sp[64 * j];
        const unsigned w4[4] = {r[j].x, r[j].y, r[j].z, r[j].w};
#pragma unroll
        for (int e = 0; e < 4; ++e) am = fmaxf(am, fmaxf(fabsf(__uint_as_float(w4[e] << 16)), fabsf(__uint_as_float(w4[e] & 0xffff0000u)))); }
#pragma unroll
    for (int o = 1; o < 64; o <<= 1) am = fmaxf(am, __shfl_xor(am, o));
    const float iv = am > 0.f ? 127.0f / am : 0.f;
    if (lane == 0) *s_out = am * (1.0f / 127.0f);
    GAS v2u* dp = (GAS v2u*)dst + lane;
#pragma unroll
    for (int j = 0; j < 8; ++j) { const unsigned w4[4] = {r[j].x, r[j].y, r[j].z, r[j].w}; unsigned o2[2];
#pragma unroll
        for (int e = 0; e < 2; ++e) o2[e] = q8x4(__uint_as_float(w4[2 * e] << 16), __uint_as_float(w4[2 * e] & 0xffff0000u), __uint_as_float(w4[2 * e + 1] << 16), __uint_as_float(w4[2 * e + 1] & 0xffff0000u), iv);
        v2u o; o.x = o2[0]; o.y = o2[1]; dp[64 * j] = o; }
}
__device__ __forceinline__ void norm_quant_row(const float* xrow, const bf16* drow, signed char* orow, float* sa_out, const LAS float* A, const LAS float* B, int lane) {
    const GAS f32x4* xr = (const GAS f32x4*)xrow + lane; const GAS v2u* dr = (const GAS v2u*)drow + lane;
    f32x4 v[16]; float s = 0.f;
#pragma unroll
    for (int j = 0; j < 16; ++j) { v[j] = add_bf4(__builtin_nontemporal_load(xr + 64 * j), dr[64 * j]); s += (v[j].x * v[j].x + v[j].y * v[j].y) + (v[j].z * v[j].z + v[j].w * v[j].w); }
    const float rstd = 1.0f / sqrtf(wave_sum(s) * (1.f / DM) + EPS);
    float am = 0.f;
#pragma unroll
    for (int j = 0; j < 16; ++j) { const f32x4 a = *(const LAS f32x4*)(A + 256 * j + 4 * lane), b = *(const LAS f32x4*)(B + 256 * j + 4 * lane);
        v[j].x = v[j].x * rstd * a.x + b.x; v[j].y = v[j].y * rstd * a.y + b.y; v[j].z = v[j].z * rstd * a.z + b.z; v[j].w = v[j].w * rstd * a.w + b.w;
        am = fmaxf(fmaxf(am, fmaxf(fabsf(v[j].x), fabsf(v[j].y))), fmaxf(fabsf(v[j].z), fabsf(v[j].w)));
        if ((j & 3) == 3) asm volatile("" ::: "memory"); }
#pragma unroll
    for (int o = 1; o < 64; o <<= 1) am = fmaxf(am, __shfl_xor(am, o));
    const float iv = am > 0.f ? 127.0f / am : 0.f;
    if (lane == 0) *sa_out = am * (1.0f / 127.0f);
    GAS unsigned* o4 = (GAS unsigned*)orow + lane;
#pragma unroll
    for (int j = 0; j < 16; ++j) o4[64 * j] = q8x4(v[j].x, v[j].y, v[j].z, v[j].w, iv);
}

constexpr int N_AMAX = 2 * 43 * 16, N_AMAXO = 16 * 16, N_AMAXD = 16 * 43;
__device__ __forceinline__ void late_slice(const Args& args, bf16* WinT, bf16* WoutT, bf16* WguT, bf16* WdT, float* MODP2, float* AMAXP, float* AMAXO, float* AMAXD, int sidx, int G, int gw, LAS float* scr, int lane) {
    const int NGW = G * 8;
    if (sidx == 0) for (int a = gw; a < 64 * KSPLIT2; a += NGW) { const int cg = a % 64, sp = a / 64;
        ada_task(args, MODC1 + cg * 256, sp * (DM / KSPLIT2), DM / KSPLIT2, MODP2 + (size_t)(sp * NMODV) * (MODW - MODC1) + cg * 256, (size_t)(MODW - MODC1), scr, lane); }
    if (sidx == 1) { for (int a_ = gw + N_AMAXD; a_ < N_AMAXD + N_AMAX + N_AMAXO; a_ += NGW) { const int a = a_ - N_AMAXD;
            if (a < N_AMAX) { const int cg = a % 86, ks = a / 86; const bool up = cg >= 43; const int col0 = (cg % 43) * 256;
                amax_task(up ? args.w_up : args.w_gate, DFF, col0, ks, AMAXP + (size_t)ks * 22016 + gu_row(col0 + 4 * lane, up), lane); }
            else { const int b2 = a - N_AMAX, cg = b2 % 16, ks = b2 / 16; amax_task(args.w_out, DM, cg * 256, ks, AMAXO + (size_t)ks * DM + cg * 256 + 4 * lane, lane); } }
        for (int a = gw; a < N_AMAXD; a += NGW) { const int cg = a % 16, ks = a / 16; amax_task_rot(args.w_down, DM, cg * 256, ks, AMAXD + (size_t)ks * DM + cg * 256 + 4 * lane, lane); } }
}

template <bool DELTA>
__device__ __forceinline__ void norm_mod_row(const float* xrow, const bf16* drow, bf16* orow, const LAS float* A, const LAS float* B, int lane) {
    const GAS f32x4* xr = (const GAS f32x4*)xrow + lane; const GAS v2u* dr = (const GAS v2u*)drow + lane;
    f32x4 v[16]; float s = 0.f;
#pragma unroll
    for (int j = 0; j < 16; ++j) { v[j] = __builtin_nontemporal_load(xr + 64 * j); if (DELTA) v[j] = add_bf4(v[j], dr[64 * j]); s += (v[j].x * v[j].x + v[j].y * v[j].y) + (v[j].z * v[j].z + v[j].w * v[j].w); }
    const float rstd = 1.0f / sqrtf(wave_sum(s) * (1.f / DM) + EPS);
    GAS v2u* o8 = (GAS v2u*)orow + lane;
#pragma unroll
    for (int j = 0; j < 16; ++j) { const f32x4 a = *(const LAS f32x4*)(A + 256 * j + 4 * lane), b = *(const LAS f32x4*)(B + 256 * j + 4 * lane);
        v2u w; w.x = pk2(v[j].x * rstd * a.x + b.x, v[j].y * rstd * a.y + b.y); w.y = pk2(v[j].z * rstd * a.z + b.z, v[j].w * rstd * a.w + b.w); o8[64 * j] = w; }
}
__device__ __forceinline__ void norm_mod_row_dual(const float* xrow, bf16* orow, signed char* qrow, float* s_out, const LAS float* A, const LAS float* B, int lane) {
    const GAS f32x4* xr = (const GAS f32x4*)xrow + lane;
    f32x4 v[16]; float s = 0.f;
#pragma unroll
    for (int j = 0; j < 16; ++j) { v[j] = __builtin_nontemporal_load(xr + 64 * j); s += (v[j].x * v[j].x + v[j].y * v[j].y) + (v[j].z * v[j].z + v[j].w * v[j].w); }
    const float rstd = 1.0f / sqrtf(wave_sum(s) * (1.f / DM) + EPS);
    GAS v2u* o8 = (GAS v2u*)orow + lane; float am = 0.f;
#pragma unroll
    for (int j = 0; j < 16; ++j) { const f32x4 a = *(const LAS f32x4*)(A + 256 * j + 4 * lane), b = *(const LAS f32x4*)(B + 256 * j + 4 * lane);
        v[j].x = v[j].x * rstd * a.x + b.x; v[j].y = v[j].y * rstd * a.y + b.y; v[j].z = v[j].z * rstd * a.z + b.z; v[j].w = v[j].w * rstd * a.w + b.w;
        v2u w; w.x = pk2(v[j].x, v[j].y); w.y = pk2(v[j].z, v[j].w); o8[64 * j] = w;
        am = fmaxf(fmaxf(am, fmaxf(fabsf(v[j].x), fabsf(v[j].y))), fmaxf(fabsf(v[j].z), fabsf(v[j].w)));
        if ((j & 3) == 3) asm volatile("" ::: "memory"); }
#pragma unroll
    for (int o = 1; o < 64; o <<= 1) am = fmaxf(am, __shfl_xor(am, o));
    const float iv = am > 0.f ? 127.0f / am : 0.f;
    if (lane == 0) *s_out = am * (1.0f / 127.0f);
    GAS unsigned* o4 = (GAS unsigned*)qrow + lane;
#pragma unroll
    for (int j = 0; j < 16; ++j) o4[64 * j] = q8x4(v[j].x, v[j].y, v[j].z, v[j].w, iv);
}

__global__ void __launch_bounds__(512, 2) mega_fwd(Args args) {
    extern __shared__ __attribute__((aligned(16))) unsigned char lds[];
    LAS unsigned char* L = (LAS unsigned char*)lds;
    volatile LAS unsigned* MISC = (volatile LAS unsigned*)(L + MISC_OFF);
    const int tid = threadIdx.x, lane = tid & 63, wave = __builtin_amdgcn_readfirstlane(tid >> 6);
    const int G = gridDim.x, bx = blockIdx.x;
    unsigned char* ws = args.ws;
    gu32* ctl = (gu32*)(ws + WS_CTL);
    float* MODP = (float*)(ws + WS_MODP); float* MOD = (float*)(ws + WS_MOD); float* MODP2 = (float*)(ws + WS_MODP2); float* AMAXP = (float*)(ws + WS_AMAXP); float* AMAXO = (float*)(ws + WS_AMAXP + 1536 * 1024); float* SWq = (float*)(ws + WS_SW); float* SWo = (float*)(ws + WS_SW + 128 * 1024);
    float* SAq = (float*)(ws + WS_SA); float* SMq = (float*)(ws + WS_SA + 128 * 1024); signed char* Wo8 = (signed char*)(ws + WS_WOUT); signed char* MIX8 = (signed char*)(ws + WS_QKV);
    float* AMAXD = (float*)(ws + WS_AMAXD); float* AMAXU = (float*)(ws + WS_AMAXD + 768 * 1024); float* AMAXQ = (float*)(ws + WS_AMAXD + 896 * 1024); float* SWqq = (float*)(ws + WS_SW + 512 * 1024); float* SWu = (float*)(ws + WS_SW + 384 * 1024); float* SHa = (float*)(ws + WS_SA + 384 * 1024);
    signed char* Wu8 = (signed char*)(ws + WS_WOUT + 16 * MiB); signed char* Wqq8 = (signed char*)(ws + WS_WOUT + 24 * MiB); signed char* Wkv8 = (signed char*)(ws + WS_MIX); float* SWkv = (float*)(ws + WS_SW + 640 * 1024); signed char* H8a = (signed char*)(ws + WS_Y + 64 * MiB); float* SWd = (float*)(ws + WS_SW + 256 * 1024); float* SActq = (float*)(ws + WS_SA + 256 * 1024);
    signed char* Wd8 = (signed char*)(ws + WS_WD); signed char* ACT8 = (signed char*)(ws + WS_WGU); unsigned* ROWMAX = (unsigned*)(ws + WS_CTL + 512 * 1024);
    signed char* Wq8 = (signed char*)(ws + WS_WGU); signed char* H8 = (signed char*)(ws + WS_H);
    bf16 *WinT = (bf16*)(ws + WS_WIN), *WoutT = (bf16*)(ws + WS_WOUT), *WguT = (bf16*)(ws + WS_WGU), *WdT = (bf16*)(ws + WS_WD);
    bf16 *CK = (bf16*)(ws + WS_CK), *CV = (bf16*)(ws + WS_CV), *DT256 = (bf16*)(ws + WS_DT256), *D2 = (bf16*)(ws + WS_D2), *DT2048 = (bf16*)(ws + WS_DT2048);
    bf16 *H = (bf16*)(ws + WS_H), *MIX = (bf16*)(ws + WS_MIX), *QKV = (bf16*)(ws + WS_QKV), *UT = (bf16*)(ws + WS_UT), *Y = (bf16*)(ws + WS_Y), *ACT = (bf16*)(ws + WS_ACT), *DL1 = (bf16*)(ws + WS_DL1), *DL2 = (bf16*)(ws + WS_DL2);
    float* OUTY = args.out; float* OUTKV = args.out + (size_t)NTOK * DM;

    for (int u = tid; u < (LDS_BYTES - LDSCTL_OFF) / 4; u += 512) ((LAS unsigned*)(L + LDSCTL_OFF))[u] = 0u;
    __syncthreads();
    XcdBarrier bar; bar.bar = (unsigned*)(ctl + CW_BAR); bar.x = 0; bar.st = nullptr;
    if (MK_N_LAUNCHES == 1) bar = xcd_barrier_post((unsigned*)(ctl + CW_BAR), MISC + 8);
    const int lo = args.ph_lo, hi = args.ph_hi;
#define IN(k) (lo <= (k) && (k) < hi)
#define SEAM(k) do { if (IN(k) && IN((k) + 1)) xcd_barrier(bar); } while (0)

    if (IN(0)) {
        const int gw = bx * 8 + wave, NGW = G * 8;
        LAS float* scr = (LAS float*)(L + wave * 16640);
        constexpr int NADA = (MODC1 / 256) * KSPLIT;
        for (int a = gw; a < NADA; a += NGW) { const int cg = a % (MODC1 / 256), sp = a / (MODC1 / 256);
            ada_task(args, cg * 256, sp * 256, 256, MODP + (size_t)(sp * NMODV) * MODW + cg * 256, (size_t)MODW, scr, lane); }
        for (int a = NGW > NADA ? (gw >= NADA ? gw - NADA : gw + NGW - NADA) : gw; a < 2 * 8 * 16; a += NGW) { const bool isq = a >= 128; const int b2 = isq ? a - 128 : a, cg = b2 % 8, ks = b2 / 8;
            amax_task(args.w_in, 8192, (isq ? 0 : 6144) + cg * 256, ks, (isq ? AMAXQ : AMAXU) + (size_t)ks * 2048 + cg * 256 + 4 * lane, lane); }
        { const int nfree = NGW - NADA;
          if (nfree >= NADA) { if (gw >= NADA) tr_run(args, WinT, WoutT, WguT, WdT, 0, gw - NADA, TR_I_IN, nfree, scr, lane); }
          else tr_run(args, WinT, WoutT, WguT, WdT, 0, gw, TR_I_IN, NGW, scr, lane); }
        const int gt = bx * 512 + tid, NGT = G * 512;
        for (int i = gt; i < 2 * 262144; i += NGT) { const bool isv = i >= 262144; const int j = isv ? i - 262144 : i;
            const GAS f32x4* src = (const GAS f32x4*)((isv ? args.cache_v : args.cache_k) + (size_t)j * 8);
            const f32x4 a = src[0], b = src[1]; v4u o; o.x = pk2(a.x, a.y); o.y = pk2(a.z, a.w); o.z = pk2(b.x, b.y); o.w = pk2(b.z, b.w);
            *(GAS v4u*)((isv ? CV : CK) + (size_t)j * 8) = o; }
        constexpr int N8_A = 2048 * 2048 / 8, N8_B = 256 * 256 / 8, N8_C = 1024 * 1024 / 8;
        for (int i = gt; i < N8_A + N8_B + N8_C; i += NGT) {
            int T, row, col8; bf16* dst; float sgn = 1.f, nrm;
            if (i < N8_A) { T = 2048; row = i / 256; col8 = (i % 256) * 8; dst = DT2048 + (size_t)row * 2048 + col8; nrm = 0.022097086912079608f; }
            else if (i < N8_A + N8_B) { const int j = i - N8_A; T = 256; row = j / 32; col8 = (j % 32) * 8; dst = DT256 + (size_t)row * 256 + col8; nrm = 0.0625f; }
            else { const int j = i - N8_A - N8_B; T = 512; row = j / 128; col8 = (j % 128) * 8; dst = D2 + (size_t)row * 1024 + col8; nrm = 0.044194173824159216f; }
            int kf, t0; bool is_sin;
            if (i < N8_A + N8_B) { const int Th = T >> 1; is_sin = row > Th; kf = is_sin ? row - Th : row; t0 = col8; }
            else { is_sin = col8 >= 512; kf = row & 511; t0 = col8 & 511; sgn = is_sin ? (row < 512 ? -1.f : 1.f) : 1.f; }
            float vals[8];
#pragma unroll
            for (int e = 0; e < 8; ++e) { const int ph = (kf * (t0 + e)) & (T - 1); const float ang = (float)ph * (2.0f / (float)T);
                vals[e] = sgn * nrm * (is_sin ? sinpif(ang) : cospif(ang)); }
            v4u o; o.x = pk2(vals[0], vals[1]); o.y = pk2(vals[2], vals[3]); o.z = pk2(vals[4], vals[5]); o.w = pk2(vals[6], vals[7]);
            *(GAS v4u*)dst = o;
        }
    }
    SEAM(0);

    if (IN(1)) {
        LAS float* A1 = (LAS float*)L; LAS float* B1 = A1 + DM;
        for (int rc = bx; rc < NTOK / 64; rc += G) {
            const int bidx = rc < 128 ? 0 : 1 + ((rc - 128) >> 5);
            __syncthreads();
#pragma unroll 1
            for (int col = tid; col < DM; col += 512) { float sh = args.b_ada[col], sc = args.b_ada[DM + col];
#pragma unroll
                for (int k = 0; k < KSPLIT; ++k) { const float* mp = MODP + ((size_t)(k * NMODV + bidx)) * MODW; sh += mp[col]; sc += mp[DM + col]; }
                A1[col] = args.norm1_g[col] * (1.0f + sc); B1[col] = sh; }
            __syncthreads();
#pragma unroll 1
            for (int i = 0; i < 8; ++i) { const int row = rc * 64 + wave * 8 + i;
                const float* xr = row < NPROMPT ? args.x_prompt + (size_t)row * DM : args.x_sample + (size_t)(row - NPROMPT) * DM;
                norm_mod_row_dual(xr, H + (size_t)row * DM, H8a + (size_t)row * DM, SHa + row, A1, B1, lane); }
        }
        __syncthreads();
        { LAS float* scr = (LAS float*)(L + wave * 16896);
          for (int it = bx * 8 + wave; it < 2 * 64 * 32; it += G * 8) { const bool isq = it >= 64 * 32; const int r = isq ? it - 64 * 32 : it, kb = r / 32, nb = r % 32;
              quant_item<16, false>(args.w_in, 8192, kb, (isq ? 0 : 6144) + nb * 64, (isq ? AMAXQ : AMAXU) + nb * 64, 2048, (isq ? Wqq8 : Wu8) + (size_t)(nb * 64) * DM + kb * 64, (size_t)DM, (isq ? SWqq : SWu) + nb * 64, scr, lane); } }
        for (int n = bx * 8 + wave; n < 2 * DATT; n += G * 8) quant_row_bf16(WinT + (size_t)(DATT + n) * DM, Wkv8 + (size_t)n * DM, SWkv + n, lane);
    }
    SEAM(1);

    if (IN(2)) {
        const int gw2 = bx * 8 + wave; LAS float* scr2 = (LAS float*)(L + wave * 16640);
        { const pg8::Gemm g = pg8::gemm_rowmajor(DM, DM, DM); pg8::QkvSched S; S.init(G, bx, H, WinT, 0, 2);
          pg8::EpiQKV E{QKV, OUTKV};
          pg8::gemm_phase<pg8::EpiQKV, pg8::QkvSched, true>(L, g, S, E); }
        __syncthreads(); late_slice(args, WinT, WoutT, WguT, WdT, MODP2, AMAXP, AMAXO, AMAXD, 0, G, gw2, scr2, lane); __syncthreads();
        if (G == 256) { const pg8::Gemm g = pg8::gemm_rowmajor(DM / 2, DM / 2, DM / 2); pg8::TileSched S;
          S.init(32, 16, 1, G, bx, H8a + (size_t)32 * 256 * DM, Wkv8, (size_t)256 * DM, (size_t)256 * DM, 0, 0); S.pm0 = 32; S.pn0 = 8;
          pg8::EpiKV8 E{QKV, SHa, SWkv};
          pg8::gemm_phase<pg8::EpiKV8, pg8::TileSched, true, true>(L, g, S, E); }
        else { const pg8::Gemm g = pg8::gemm_rowmajor(DM, DM, DM); pg8::QkvSched S; S.init(G, bx, H, WinT, 2, 1 << 20);
          pg8::EpiQKV E{QKV, OUTKV};
          pg8::gemm_phase<pg8::EpiQKV, pg8::QkvSched, true>(L, g, S, E); }
        __syncthreads(); late_slice(args, WinT, WoutT, WguT, WdT, MODP2, AMAXP, AMAXO, AMAXD, 1, G, gw2, scr2, lane); __syncthreads();
        { const pg8::Gemm g = pg8::gemm_rowmajor(DM / 2, DM / 2, DM / 2); pg8::TileSched S; S.init(64, 8, 1, G, bx, H8a, Wqq8, (size_t)256 * DM, (size_t)256 * DM, 0, 0);
          pg8::EpiQ8 E{QKV, SHa, SWqq};
          pg8::gemm_phase<pg8::EpiQ8, pg8::TileSched, true, true>(L, g, S, E); }
        { const pg8::Gemm g = pg8::gemm_rowmajor(DM / 2, DM / 2, DM / 2); pg8::TileSched S; S.init(8, 64, 1, G, bx, Wu8, H8a, (size_t)256 * DM, (size_t)256 * DM, 0, 0);
          pg8::EpiUT8 E{UT, SWu, SHa};
          pg8::gemm_phase<pg8::EpiUT8, pg8::TileSched, true, true>(L, g, S, E); }
    }
    SEAM(2);

    if (IN(3)) {
        const bf16* Qb = QKV; const bf16* Kb = QKV + (size_t)NTOK * DATT; const bf16* Vb = QKV + (size_t)2 * NTOK * DATT;
        for (int u = bx; u < 512; u += G) {
            const int b = u >> 4, h = u & 15; const size_t ro = (size_t)(b * 256) * DATT + h * HD;
            att::AttnUnit U{Qb + ro, Kb + ro, Vb + ro, Kb + ro, Vb + ro, MIX + (size_t)(b * 256) * DM + h * HD, nullptr, 4, 0, 0, 0};
            att::attn_unit<false>(U, (char*)lds);
        }
        for (int u = bx; u < 512; u += G) {
            const int rb = u & 7, h = (u >> 3) & 15, b = u >> 7, r0 = rb * 4;
            const int kr0 = rb == 0 ? 0 : (rb == 7 ? 24 : r0 - 4), n0 = (rb == 0 || rb == 7) ? 8 : 12;
            const size_t tok0 = NPROMPT + (size_t)b * 2048; const size_t co = (size_t)(b * 256) * DATT + h * HD;
            att::AttnUnit U{Qb + (tok0 + r0 * 64) * DATT + h * HD, Kb + (tok0 + kr0 * 64) * DATT + h * HD, Vb + (tok0 + kr0 * 64) * DATT + h * HD,
                            CK + co, CV + co, MIX + (tok0 + r0 * 64) * DM + h * HD, args.rpb + h * 15 * 31, n0, 4, r0, kr0};
            att::attn_unit<true>(U, (char*)lds);
        }
        __syncthreads();
        { const pg8::Gemm g = pg8::gemm_rowmajor(256, NTOK, 256); pg8::TileSched S; S.init(1, 8, 32, G, bx, DT256, UT, (size_t)256 * 256 * 2, (size_t)256 * NTOK * 2, 0, (size_t)256 * 2);
          pg8::EpiY2 E{Y, 128, 0};
          pg8::gemm_phase<pg8::EpiY2, pg8::TileSched, true>(L, g, S, E); }
        { const pg8::Gemm g = pg8::gemm_rowmajor(2048, NTOK, 2048); pg8::TileSched S; S.init(8, 8, 4, G, bx, DT2048, UT + NPROMPT, (size_t)256 * 2048 * 2, (size_t)256 * NTOK * 2, 0, (size_t)2048 * 2);
          pg8::EpiY2 E{Y, 1024, 4096};
          pg8::gemm_phase<pg8::EpiY2, pg8::TileSched, true>(L, g, S, E); }
    }
    SEAM(3);

    if (IN(4)) {
        for (int idx = bx * 512 + tid; idx < NMODV * MODW; idx += G * 512) { const int v = idx / MODW, j = idx % MODW; float sm = args.b_ada[j];
            if (j < MODC1) {
#pragma unroll
                for (int k = 0; k < KSPLIT; ++k) sm += MODP[((size_t)(k * NMODV + v)) * MODW + j]; }
            else {
#pragma unroll 8
                for (int k = 0; k < KSPLIT2; ++k) sm += MODP2[((size_t)(k * NMODV + v)) * (MODW - MODC1) + (j - MODC1)]; }
            MOD[idx] = sm; }
        { LAS float* scr = (LAS float*)(L + wave * 16896);
          for (int it = bx * 8 + wave; it < TR_I_OUT; it += G * 8) { const int kb = it / 64, nb = it % 64; quant_item<16, false>(args.w_out, DM, kb, nb * 64, AMAXO + nb * 64, DM, Wo8 + (size_t)(nb * 64) * DM + kb * 64, (size_t)DM, SWo + nb * 64, scr, lane); } }
        __syncthreads();
        for (int t = bx * 8 + wave; t < 36 * 4 * 2 * 8; t += G * 8) {
            const int chunk = t & 7, which = (t >> 3) & 1, g = (t >> 4) & 3, bb = t >> 6;
            int R, T, tok0; if (bb < 32) { R = bb * 128; T = 256; tok0 = bb * 256; } else { R = 4096 + (bb - 32) * 1024; T = 2048; tok0 = NPROMPT + (bb - 32) * 2048; }
            const GAS v4u* yp = (const GAS v4u*)(Y + (size_t)R * DM + g * 1024 + which * 512);
            const int kc = chunk * 64 + lane; const GAS v4u* dp = (const GAS v4u*)(D2 + (size_t)kc * 1024);
            float a0 = 0.f, a1 = 0.f;
#pragma unroll 16
            for (int c8 = 0; c8 < 64; ++c8) { const v4u y = yp[c8], d = dp[c8];
                a0 += __uint_as_float(y.x << 16) * __uint_as_float(d.x << 16); a1 += __uint_as_float(y.x & 0xffff0000u) * __uint_as_float(d.x & 0xffff0000u);
                a0 += __uint_as_float(y.y << 16) * __uint_as_float(d.y << 16); a1 += __uint_as_float(y.y & 0xffff0000u) * __uint_as_float(d.y & 0xffff0000u);
                a0 += __uint_as_float(y.z << 16) * __uint_as_float(d.z << 16); a1 += __uint_as_float(y.z & 0xffff0000u) * __uint_as_float(d.z & 0xffff0000u);
                a0 += __uint_as_float(y.w << 16) * __uint_as_float(d.w << 16); a1 += __uint_as_float(y.w & 0xffff0000u) * __uint_as_float(d.w & 0xffff0000u); }
            MIX[(size_t)(tok0 + (which ? (T >> 1) : 0)) * DM + DATT + g * 512 + kc] = (bf16)f2bf(a0 + a1);
        }
        const pg8::Gemm g = pg8::gemm_rowmajor(DM, 1024, 1024); pg8::TileSched S; S.init(32, 4, 4, G, bx, Y, D2, (size_t)256 * DM * 2, (size_t)256 * 1024 * 2, (size_t)1024 * 2, 0);
        pg8::EpiF2x E{MIX};
        pg8::gemm_phase<pg8::EpiF2x, pg8::TileSched, true>(L, g, S, E);
    }
    SEAM(4);

    if (IN(5)) {
        for (int row = bx * 8 + wave; row < NTOK; row += G * 8) quant_row_bf16(MIX + (size_t)row * DM, MIX8 + (size_t)row * DM, SMq + row, lane);
        for (int n = bx * 512 + tid; n < DM; n += G * 512) { float am = 0.f;
#pragma unroll
            for (int p = 0; p < 43; ++p) am = fmaxf(am, AMAXD[(size_t)p * DM + n]);
            SWd[n] = am * (1.0f / 127.0f); }
    }
    SEAM(5);

    if (IN(6)) {
        const pg8::Gemm g = pg8::gemm_rowmajor(DM / 2, DM / 2, DM / 2); pg8::TileSched S; S.init(64, 16, 1, G, bx, MIX8, Wo8, (size_t)256 * DM, (size_t)256 * DM, 0, 0);
        pg8::EpiDelta8 E{DL1, MOD + 2 * DM, SMq, SWo};
        pg8::gemm_phase<pg8::EpiDelta8, pg8::TileSched, true, true>(L, g, S, E);
    }
    SEAM(6);

    if (IN(7)) {
        LAS float* A1 = (LAS float*)L; LAS float* B1 = A1 + DM;
        for (int rc = bx; rc < NTOK / 64; rc += G) {
            const int bidx = rc < 128 ? 0 : 1 + ((rc - 128) >> 5);
            __syncthreads();
#pragma unroll 2
            for (int col = tid; col < DM; col += 512) { const float* mp = MOD + (size_t)bidx * MODW; A1[col] = args.norm2_g[col] * (1.0f + mp[4 * DM + col]); B1[col] = mp[3 * DM + col]; }
            __syncthreads();
#pragma unroll 1
            for (int i = 0; i < 8; ++i) { const int row = rc * 64 + wave * 8 + i;
                const float* xr = row < NPROMPT ? args.x_prompt + (size_t)row * DM : args.x_sample + (size_t)(row - NPROMPT) * DM;
                norm_quant_row(xr, DL1 + (size_t)row * DM, H8 + (size_t)row * DM, SAq + row, A1, B1, lane); }
        }
        __syncthreads();
        { LAS float* scr = (LAS float*)(L + wave * 16896);
          for (int it = bx * 8 + wave; it < 2 * TR_I_G; it += G * 8) { const bool up = it >= TR_I_G; const int r = up ? it - TR_I_G : it; const int kb = r / 172, n0 = (r % 172) * 64, r0 = gu_row(n0, up); quant_item<16, false>(up ? args.w_up : args.w_gate, DFF, kb, n0, AMAXP + r0, 22016, Wq8 + (size_t)r0 * DM + kb * 64, (size_t)DM, SWq + r0, scr, lane); } }
        { LAS float* scr = (LAS float*)(L + wave * 16896);
          for (int it = bx * 8 + wave; it < TR_I_D; it += G * 8) { const int kb = it / 64, nb = it % 64;
              quant_item<0, true>(args.w_down, DM, kb, nb * 64, nullptr, 0, Wd8 + ((size_t)((nb >> 2) * (DFF / 128) + (kb >> 1)) * 256 + (nb & 3) * 64) * 128 + (kb & 1) * 64, (size_t)128, SWd + nb * 64, scr, lane); } }
    }
    SEAM(7);

    if (IN(8)) {
        const pg8::Gemm g = pg8::gemm_rowmajor(DM / 2, DM / 2, DM / 2); pg8::TileSched S; S.init(64, 86, 1, G, bx, H8, Wq8, (size_t)256 * DM, (size_t)256 * DM, 0, 0);
        pg8::EpiSwiglu8 E{ACT, SAq, SWq};
        pg8::gemm_phase<pg8::EpiSwiglu8, pg8::TileSched, true, true>(L, g, S, E);
    }
    SEAM(8);

    if (IN(9)) {
        for (int row = bx * 8 + wave; row < NTOK; row += G * 8) {
            const GAS v4u* src = (const GAS v4u*)(ACT + (size_t)row * DFF) + lane; v4u r[22]; float mx = 0.f;
#pragma unroll
            for (int i = 0; i < 22; ++i) r[i] = (i < 21 || lane < 32) ? __builtin_nontemporal_load(src + 64 * i) : (v4u){0u, 0u, 0u, 0u};
#pragma unroll
            for (int i = 0; i < 22; ++i) { float a[8] = {__uint_as_float(r[i].x << 16), __uint_as_float(r[i].x & 0xffff0000u), __uint_as_float(r[i].y << 16), __uint_as_float(r[i].y & 0xffff0000u),
                                                     __uint_as_float(r[i].z << 16), __uint_as_float(r[i].z & 0xffff0000u), __uint_as_float(r[i].w << 16), __uint_as_float(r[i].w & 0xffff0000u)};
                pg8::wht8(a);
                r[i].x = pg8::cvt_pk_bf16(a[0], a[1]); r[i].y = pg8::cvt_pk_bf16(a[2], a[3]); r[i].z = pg8::cvt_pk_bf16(a[4], a[5]); r[i].w = pg8::cvt_pk_bf16(a[6], a[7]);
                mx = fmaxf(mx, fmaxf(fmaxf(fmaxf(fabsf(a[0]), fabsf(a[1])), fmaxf(fabsf(a[2]), fabsf(a[3]))), fmaxf(fmaxf(fabsf(a[4]), fabsf(a[5])), fmaxf(fabsf(a[6]), fabsf(a[7]))))); }
#pragma unroll
            for (int o = 1; o < 64; o <<= 1) mx = fmaxf(mx, __shfl_xor(mx, o));
            const float rm = __uint_as_float(pg8::cvt_pk_bf16(mx, mx) << 16);
            const float iv = rm > 0.f ? 127.0f / rm : 0.f;
            if (lane == 0) SActq[row] = rm * (1.0f / 127.0f);
            signed char* dst = ACT8 + ((size_t)(row >> 8) * (DFF / 128) * 256 + (row & 255)) * 128;
#pragma unroll
            for (int i = 0; i < 22; ++i) if (i < 21 || lane < 32) { const int ch = lane + 64 * i;
                v2u o; o.x = q8x4(__uint_as_float(r[i].x << 16), __uint_as_float(r[i].x & 0xffff0000u), __uint_as_float(r[i].y << 16), __uint_as_float(r[i].y & 0xffff0000u), iv);
                o.y = q8x4(__uint_as_float(r[i].z << 16), __uint_as_float(r[i].z & 0xffff0000u), __uint_as_float(r[i].w << 16), __uint_as_float(r[i].w & 0xffff0000u), iv);
                *(GAS v2u*)(dst + (size_t)(ch >> 4) * 256 * 128 + (ch & 15) * 8) = o; }
        }
    }
    SEAM(9);

    if (IN(10)) {
        const pg8::Gemm g{64, 64, DFF / 2, (size_t)32768, (size_t)32768, (size_t)16384, (size_t)16384};
        pg8::TileSched S; S.init(64, 16, 1, G, bx, ACT8, Wd8, (size_t)256 * DFF, (size_t)256 * DFF, 0, 0);
        S.wgm = 2;
        pg8::EpiDelta8 E{DL2, MOD + 5 * DM, SActq, SWd};
        pg8::gemm_phase<pg8::EpiDelta8, pg8::TileSched, true, true>(L, g, S, E);
    }
    SEAM(10);

    if (IN(11)) {
        for (int row = bx * 8 + wave; row < NTOK; row += G * 8) {
            const float* xrow = row < NPROMPT ? args.x_prompt + (size_t)row * DM : args.x_sample + (size_t)(row - NPROMPT) * DM;
            const GAS f32x4* xr = (const GAS f32x4*)xrow + lane; const GAS f32x4* gr = (const GAS f32x4*)args.final_g + lane;
            const GAS v2u* d1 = (const GAS v2u*)(DL1 + (size_t)row * DM) + lane; const GAS v2u* d2 = (const GAS v2u*)(DL2 + (size_t)row * DM) + lane;
            GAS f32x4* yr = (GAS f32x4*)(OUTY + (size_t)row * DM) + lane;
            f32x4 v[16]; float s = 0.f;
#pragma unroll
            for (int j = 0; j < 16; ++j) { v[j] = add_bf4(add_bf4(__builtin_nontemporal_load(xr + 64 * j), __builtin_nontemporal_load(d1 + 64 * j)), __builtin_nontemporal_load(d2 + 64 * j)); s += (v[j].x * v[j].x + v[j].y * v[j].y) + (v[j].z * v[j].z + v[j].w * v[j].w); }
            const float rstd = 1.0f / sqrtf(wave_sum(s) * (1.f / DM) + EPS);
#pragma unroll
            for (int j = 0; j < 16; ++j) __builtin_nontemporal_store(v[j] * rstd * gr[64 * j], yr + 64 * j);
        }
    }
#undef IN
#undef SEAM
}

extern "C" void kernel_launch(void* const* d_in, const int* in_sizes, int n_in, void* d_out, int out_size, void* d_ws, size_t ws_size, hipStream_t stream) {
    static int grid = 0;
    if (grid == 0) {
        if (n_in != 17 || ws_size < WS_END) { fprintf(stderr, "kernel_launch: need 17 inputs and >= %zu bytes of workspace; got %d, %zu\n", (size_t)WS_END, n_in, ws_size); grid = -1; return; }
        int dev = 0, cus = 0, per_cu = 0;
        if (hipGetDevice(&dev) != hipSuccess || hipDeviceGetAttribute(&cus, hipDeviceAttributeMultiprocessorCount, dev) != hipSuccess) { grid = -1; return; }
        if (hipFuncSetAttribute((const void*)mega_fwd, hipFuncAttributeMaxDynamicSharedMemorySize, LDS_BYTES) != hipSuccess) { fprintf(stderr, "kernel_launch: hipFuncSetAttribute failed\n"); grid = -1; return; }
        if (hipOccupancyMaxActiveBlocksPerMultiprocessor(&per_cu, (const void*)mega_fwd, 512, LDS_BYTES) != hipSuccess || per_cu < 1)
            fprintf(stderr, "kernel_launch: note: occupancy query reports %d workgroups per CU\n", per_cu);
        (void)hipGetLastError();
        grid = cus;
    }
    if (grid < 0) return;
    if (hipMemsetAsync((char*)d_ws + WS_CTL, 0, CTL_ZERO_BYTES, stream) != hipSuccess) return;
    Args a{};
    a.x_prompt = (const float*)d_in[0]; a.x_sample = (const float*)d_in[1]; a.cache_k = (const float*)d_in[2]; a.cache_v = (const float*)d_in[3];
    a.c = (const float*)d_in[4]; a.c_ctx = (const float*)d_in[5]; a.w_ada = (const float*)d_in[6]; a.b_ada = (const float*)d_in[7]; a.norm1_g = (const float*)d_in[8];
    a.w_in = (const float*)d_in[9]; a.rpb = (const float*)d_in[10]; a.w_out = (const float*)d_in[11]; a.norm2_g = (const float*)d_in[12];
    a.w_gate = (const float*)d_in[13]; a.w_up = (const float*)d_in[14]; a.w_down = (const float*)d_in[15]; a.final_g = (const float*)d_in[16];
    a.out = (float*)d_out; a.ws = (unsigned char*)d_ws;
    constexpr int NPH = 12;
    if (MK_N_LAUNCHES == 1) {
        a.ph_lo = 0; a.ph_hi = NPH;
        hipLaunchKernelGGL(mega_fwd, dim3(grid), dim3(512), LDS_BYTES, stream, a);
    } else {
        for (int p = 0; p < NPH; ++p) { a.ph_lo = p; a.ph_hi = p + 1; hipLaunchKernelGGL(mega_fwd, dim3(grid), dim3(512), LDS_BYTES, stream, a);
        }
    }
    const hipError_t le = hipPeekAtLastError();
    if (le != hipSuccess) fprintf(stderr, "kernel_launch: launch failed: %s\n", hipGetErrorName(le));
}
```
